# Optimizing an MI355X kernel written in HIP

```python
import math
import jax, jax.numpy as jnp
from jax import lax
import numpy as np

D_MODEL = 2048
BATCH = 1
SEQ = 8192
DEPTH = 1

N_ATTN_HEADS = 16
HEAD_DIM = 64
ATTN_WIDTH = N_ATTN_HEADS * HEAD_DIM
CONV_CHANNELS = D_MODEL - ATTN_WIDTH
CONV_WIDTH = 31
MIX_WIDTH = CONV_CHANNELS + ATTN_WIDTH
IN_WIDTH = 2 * CONV_CHANNELS + 3 * ATTN_WIDTH
DILATED_PATTERNS = ((128, 1), (512, 4), (2048, 16))
BLOCK = 128
NUM_BUCKETS = 32
MAX_DISTANCE = 2048
N_GROUPS = 4
EXPERTS_PER_GROUP = 8
EXPERT_TOP_K = 2
D_FF_EXPERT = D_MODEL // 2
NORM_EPS = 1e-6
NEG_INF = -1e30

kernel_name = "hymba_conformer_dilated_hmoe_layer"


def _rmsnorm(x, g):
    xf = x.astype(jnp.float32)
    y = xf * lax.rsqrt(jnp.mean(xf * xf, axis=-1, keepdims=True) + NORM_EPS)
    return (y * g.astype(jnp.float32)).astype(x.dtype)


def _layernorm(x, g, b):
    xf = x.astype(jnp.float32)
    mu = jnp.mean(xf, axis=-1, keepdims=True)
    var = jnp.mean(jnp.square(xf - mu), axis=-1, keepdims=True)
    y = (xf - mu) * lax.rsqrt(var + NORM_EPS)
    return (y * g.astype(jnp.float32) + b.astype(jnp.float32)).astype(x.dtype)


def _t5_bucket(dist):
    max_exact = NUM_BUCKETS // 2
    nf = jnp.maximum(dist, 1).astype(jnp.float32)
    large = max_exact + (jnp.log(nf / max_exact) / math.log(MAX_DISTANCE / max_exact)
                         * (NUM_BUCKETS - max_exact)).astype(jnp.int32)
    large = jnp.minimum(large, NUM_BUCKETS - 1)
    return jnp.where(dist < max_exact, dist, large)


def _conv_mixer(a_val, a_gate, conv_w, conv_b, ln_g, ln_b):
    u = a_val * jax.nn.sigmoid(a_gate)
    kern = conv_w.astype(u.dtype)[:, None, :]
    u = lax.conv_general_dilated(u, kern, window_strides=(1,), padding=[(CONV_WIDTH - 1, 0)],
                                 dimension_numbers=("NWC", "WIO", "NWC"),
                                 feature_group_count=CONV_CHANNELS) + conv_b.astype(u.dtype)
    return jax.nn.silu(_layernorm(u, ln_g, ln_b))


def _dilated_window_attention(q, k, v, rel_bias, window, dilation):
    B, H, S, hd = q.shape
    span = window // dilation
    assert span <= BLOCK
    chunk = dilation * BLOCK
    s_pad = -(-S // chunk) * chunk
    L = s_pad // dilation
    nb = L // BLOCK
    padw = ((0, 0), (0, 0), (0, s_pad - S), (0, 0))

    def to_blocks(t):
        t = jnp.pad(t, padw).reshape(B, H, L, dilation, hd).transpose(0, 1, 3, 2, 4)
        return t.reshape(B, H, dilation, nb, BLOCK, hd)

    def with_prev(t):
        prev = jnp.pad(t[:, :, :, :-1], ((0, 0), (0, 0), (0, 0), (1, 0), (0, 0), (0, 0)))
        return jnp.concatenate([prev, t], axis=4)

    qb = to_blocks(q)
    kc = with_prev(to_blocks(k))
    vc = with_prev(to_blocks(v))

    qi = jnp.arange(BLOCK)[:, None]
    kj = jnp.arange(2 * BLOCK)[None, :]
    rel = BLOCK + qi - kj
    in_band = (rel >= 0) & (rel <= span)
    key_idx = jnp.arange(nb)[:, None, None] * BLOCK + kj[None] - BLOCK
    mask = in_band[None] & (key_idx >= 0)
    bucket = _t5_bucket(jnp.clip(rel, 0, span) * dilation)
    bias = jnp.transpose(rel_bias.astype(jnp.float32)[bucket], (2, 0, 1))

    scale = 1.0 / math.sqrt(hd)
    scores = jnp.einsum("bhrnqd,bhrnkd->bhrnqk", qb, kc) * scale + bias[None, :, None, None]
    scores = jnp.where(mask[None, None, None], scores, NEG_INF)
    m = jnp.max(scores, axis=-1, keepdims=True)
    p = jnp.exp(scores - m)
    denom = jnp.sum(p, axis=-1)
    o = jnp.einsum("bhrnqk,bhrnkd->bhrnqd", p, vc) / denom[..., None]
    lse = m[..., 0] + jnp.log(denom)

    o = o.reshape(B, H, dilation, L, hd).transpose(0, 1, 3, 2, 4).reshape(B, H, s_pad, hd)[:, :, :S]
    lse = lse.reshape(B, H, dilation, L).transpose(0, 1, 3, 2).reshape(B, H, s_pad)[:, :, :S]
    return o, lse


def _dilated_attention_mixer(q, k, v, q_g, k_g, rel_bias):
    B, S, _ = q.shape
    qh = _rmsnorm(q.reshape(B, S, N_ATTN_HEADS, HEAD_DIM), q_g).astype(jnp.float32).transpose(0, 2, 1, 3)
    kh = _rmsnorm(k.reshape(B, S, N_ATTN_HEADS, HEAD_DIM), k_g).astype(jnp.float32).transpose(0, 2, 1, 3)
    vh = v.reshape(B, S, N_ATTN_HEADS, HEAD_DIM).astype(jnp.float32).transpose(0, 2, 1, 3)
    outs, lses = [], []
    for window, dilation in DILATED_PATTERNS:
        o, lse = _dilated_window_attention(qh, kh, vh, rel_bias, window, dilation)
        outs.append(o)
        lses.append(lse)
    o = jnp.stack(outs)
    wts = jax.nn.softmax(jnp.stack(lses), axis=0)
    o = jnp.sum(wts[..., None] * o, axis=0)
    return o.transpose(0, 2, 1, 3).reshape(B, S, ATTN_WIDTH).astype(q.dtype)


def _hier_moe(xn, w_rg, b_rg, w_re, b_re, w_gate, w_up, w_down):
    B, S, D = xn.shape
    t = xn.reshape(B * S, D)
    glog = (t @ w_rg + b_rg).astype(jnp.float32)
    gprob = jax.nn.softmax(glog, axis=-1)
    _, gidx = lax.top_k(glog, 1)
    gw = jnp.take_along_axis(gprob, gidx, axis=1)[:, 0]
    elog = (jnp.einsum("td,gde->tge", t, w_re) + b_re).astype(jnp.float32)
    elog_sel = jnp.take_along_axis(elog, gidx[:, :, None], axis=1)[:, 0]
    top_v, top_i = lax.top_k(elog_sel, EXPERT_TOP_K)
    top_w = jax.nn.softmax(top_v, axis=-1)
    ew = jnp.sum(jax.nn.one_hot(top_i, EXPERTS_PER_GROUP, dtype=jnp.float32) * top_w[..., None], axis=1)
    gate = (jax.nn.one_hot(gidx[:, 0], N_GROUPS, dtype=jnp.float32)[:, :, None]
            * (gw[:, None] * ew)[:, None, :]).astype(t.dtype)
    y = jnp.zeros_like(t)
    for g in range(N_GROUPS):
        h = (jax.nn.silu(jnp.einsum("td,edf->tef", t, w_gate[g]))
             * jnp.einsum("td,edf->tef", t, w_up[g]) * gate[:, g, :, None])
        y = y + jnp.einsum("tef,efd->td", h, w_down[g])
    return y.reshape(B, S, D)


def setup_inputs(seed: int = 0) -> dict:
    key = jax.random.key(seed)
    ks = jax.random.split(key, 20)
    f32 = jnp.float32
    nrm = lambda k, shape, s: jax.random.normal(k, shape, f32) * s
    return {
        "x": nrm(ks[0], (BATCH, SEQ, D_MODEL), 1.0),
        "norm1_g": 1.0 + nrm(ks[1], (DEPTH, D_MODEL), 0.02),
        "w_in": nrm(ks[2], (DEPTH, D_MODEL, IN_WIDTH), D_MODEL ** -0.5),
        "q_norm_g": 1.0 + nrm(ks[3], (DEPTH, HEAD_DIM), 0.02),
        "k_norm_g": 1.0 + nrm(ks[4], (DEPTH, HEAD_DIM), 0.02),
        "conv_w": nrm(ks[5], (DEPTH, CONV_WIDTH, CONV_CHANNELS), CONV_WIDTH ** -0.5),
        "conv_b": nrm(ks[6], (DEPTH, CONV_CHANNELS), 0.02),
        "conv_ln_g": 1.0 + nrm(ks[7], (DEPTH, CONV_CHANNELS), 0.02),
        "conv_ln_b": nrm(ks[8], (DEPTH, CONV_CHANNELS), 0.02),
        "rel_bias": nrm(ks[9], (NUM_BUCKETS, N_ATTN_HEADS), 0.1),
        "w_out": nrm(ks[10], (DEPTH, MIX_WIDTH, D_MODEL), MIX_WIDTH ** -0.5),
        "norm2_g": 1.0 + nrm(ks[11], (DEPTH, D_MODEL), 0.02),
        "w_router_group": nrm(ks[12], (DEPTH, D_MODEL, N_GROUPS), D_MODEL ** -0.5),
        "b_router_group": nrm(ks[13], (DEPTH, N_GROUPS), 0.01),
        "w_router_expert": nrm(ks[14], (DEPTH, N_GROUPS, D_MODEL, EXPERTS_PER_GROUP), D_MODEL ** -0.5),
        "b_router_expert": nrm(ks[15], (DEPTH, N_GROUPS, EXPERTS_PER_GROUP), 0.01),
        "w_gate": nrm(ks[16], (DEPTH, N_GROUPS, EXPERTS_PER_GROUP, D_MODEL, D_FF_EXPERT), D_MODEL ** -0.5),
        "w_up": nrm(ks[17], (DEPTH, N_GROUPS, EXPERTS_PER_GROUP, D_MODEL, D_FF_EXPERT), D_MODEL ** -0.5),
        "w_down": nrm(ks[18], (DEPTH, N_GROUPS, EXPERTS_PER_GROUP, D_FF_EXPERT, D_MODEL), D_FF_EXPERT ** -0.5),
    }


def reference(x, norm1_g, w_in, q_norm_g, k_norm_g, conv_w, conv_b, conv_ln_g, conv_ln_b,
              rel_bias, w_out, norm2_g, w_router_group, b_router_group, w_router_expert,
              b_router_expert, w_gate, w_up, w_down):
    C, A = CONV_CHANNELS, ATTN_WIDTH
    for layer in range(DEPTH):
        xn = _rmsnorm(x, norm1_g[layer])
        proj = xn @ w_in[layer]
        a_val, a_gate, q, k, v = jnp.split(proj, [C, 2 * C, 2 * C + A, 2 * C + 2 * A], axis=-1)
        conv_out = _conv_mixer(a_val, a_gate, conv_w[layer], conv_b[layer],
                               conv_ln_g[layer], conv_ln_b[layer])
        attn_out = _dilated_attention_mixer(q, k, v, q_norm_g[layer], k_norm_g[layer], rel_bias)
        x = x + jnp.concatenate([conv_out, attn_out], axis=-1) @ w_out[layer]
        hn = _rmsnorm(x, norm2_g[layer])
        x = x + _hier_moe(hn, w_router_group[layer], b_router_group[layer], w_router_expert[layer],
                          b_router_expert[layer], w_gate[layer], w_up[layer], w_down[layer])
    return x
```

```cpp
#include <hip/hip_runtime.h>
#include <cstdio>
#include <cstdint>

#ifndef MK_N_LAUNCHES
#define MK_N_LAUNCHES 1
#endif
constexpr int N_LAUNCHES = MK_N_LAUNCHES;
constexpr int N_PHASES = 8;

#define GAS __attribute__((address_space(1)))
#define LAS __attribute__((address_space(3)))
typedef unsigned short bf16;
typedef unsigned v4u __attribute__((ext_vector_type(4)));
typedef unsigned v2u __attribute__((ext_vector_type(2)));
typedef float f32x4 __attribute__((ext_vector_type(4)));
typedef float f32x2 __attribute__((ext_vector_type(2)));
typedef short bf16x8 __attribute__((ext_vector_type(8)));
typedef short s16x4 __attribute__((ext_vector_type(4)));
typedef GAS unsigned gu32;
typedef int v8i __attribute__((ext_vector_type(8)));
typedef int v4i __attribute__((ext_vector_type(4)));
#define RLX_AGENT __ATOMIC_RELAXED, __HIP_MEMORY_SCOPE_AGENT
#define LDS_WAIT() asm volatile("s_waitcnt lgkmcnt(0)" ::: "memory")
#define VM_WAIT() asm volatile("s_waitcnt vmcnt(0)" ::: "memory")

constexpr int SEQ = 8192, DM = 2048, CCH = 1024, AW = 1024, NH = 16, HD = 64, INW = 5120, CONVW = 31;
constexpr int NGRP = 4, EPG = 8, NEXP = 32, DFF = 1024;
constexpr float NORM_EPS = 1e-6f;
constexpr float LOG2E = 1.4426950408889634f;
constexpr float C2 = 0.125f * LOG2E;
constexpr int MAXT = 96;
constexpr int MAXU = 3;

constexpr size_t MiB = 1u << 20;
constexpr size_t WS_CTL = 0, CTL_ZERO_BYTES = 40960;
constexpr size_t WS_LTOK = 1 * MiB;
constexpr size_t WS_LW = 2 * MiB;
constexpr size_t WS_BTIN = 4 * MiB;
constexpr size_t WS_BTOUT = 24 * MiB;
constexpr size_t WS_XN = 32 * MiB;
constexpr size_t WS_U = 64 * MiB;
constexpr size_t WS_Q = 80 * MiB, WS_K = 96 * MiB, WS_V = 112 * MiB;
constexpr size_t WS_MIX = 128 * MiB;
constexpr size_t WS_H = 160 * MiB;
constexpr size_t WS_BTGU = 208 * MiB;
constexpr size_t WS_BTD = 464 * MiB;
constexpr size_t WS_Y = 592 * MiB;
constexpr size_t WS_END = 688 * MiB;
constexpr size_t WS_TOKPOS = 3 * MiB;
constexpr size_t WS_RSTD = 3 * MiB + 65536;
constexpr size_t WS_WRH = 3 * MiB + 131072;
constexpr size_t WS_WRL = WS_WRH + 48 * 2048 * 2;
constexpr int CW_BAR = 0;
constexpr int CW_CNT = 4096;
static_assert((CW_CNT + 64 * 32) * 4 <= (int)CTL_ZERO_BYTES && 3456 <= CW_CNT, "control words inside the zeroed region");

constexpr int RING_BYTES = 131072;
constexpr int MOE_TOK_OFF = RING_BYTES;
constexpr int MOE_W_OFF = MOE_TOK_OFF + MAXU * 1024;
constexpr int MOE_R_OFF = MOE_W_OFF + MAXU * 1024;
constexpr int MOE_TB_OFF = MOE_R_OFF + MAXU * 1024;
constexpr int MISC_OFF = MOE_TB_OFF + 512;
constexpr int LDS_BYTES = 147456;
static_assert(MISC_OFF + 64 <= LDS_BYTES, "LDS map");

__device__ __forceinline__ unsigned f2bf(float f) { unsigned u = __builtin_bit_cast(unsigned, f); return (u + 0x7fffu + ((u >> 16) & 1u)) >> 16; }
__device__ __forceinline__ unsigned pk2(float lo, float hi) { return f2bf(lo) | (f2bf(hi) << 16); }
__device__ __forceinline__ unsigned cvt_pk_bf16(float lo, float hi) { unsigned r; asm volatile("v_cvt_pk_bf16_f32 %0, %1, %2" : "=v"(r) : "v"(lo), "v"(hi)); return r; }
typedef __bf16 bf16x2_t __attribute__((ext_vector_type(2)));
__device__ __forceinline__ unsigned cvt_pk_s(float lo, float hi) { const f32x2 v = {lo, hi}; const bf16x2_t b = __builtin_convertvector(v, bf16x2_t); return __builtin_bit_cast(unsigned, b); }
__device__ __forceinline__ unsigned pk4_fp8(float a, float b, float c, float d) { int p = 0; p = __builtin_amdgcn_cvt_pk_fp8_f32(a, b, p, false); p = __builtin_amdgcn_cvt_pk_fp8_f32(c, d, p, true); return (unsigned)p; }
constexpr float W8_SCALE = 64.f, H8_SCALE = 16.f;
__device__ __forceinline__ float bf_lo(unsigned u) { return __builtin_bit_cast(float, u << 16); }
__device__ __forceinline__ float bf_hi(unsigned u) { return __builtin_bit_cast(float, u & 0xffff0000u); }
__device__ __forceinline__ float sigmoidf_(float x) { return __builtin_amdgcn_rcpf(1.f + __expf(-x)); }
__device__ __forceinline__ int lane_id_v() { int l; asm volatile("v_mbcnt_lo_u32_b32 %0, -1, 0\n\tv_mbcnt_hi_u32_b32 %0, -1, %0" : "=v"(l)); return l; }
__device__ __forceinline__ float wave_sum(float v) {
#pragma unroll
    for (int o = 1; o < 64; o <<= 1) v += __shfl_xor(v, o);
    return v;
}

__constant__ unsigned char kBucket[3][132] = {
 {0,1,2,3,4,5,6,7,8,9,10,11,12,13,14,15,16,16,16,16,16,16,17,17,17,17,17,17,17,17,18,18,18,18,18,18,18,18,18,18,19,19,19,19,19,19,19,19,19,19,19,19,19,19,20,20,20,20,20,20,20,20,20,20,20,20,20,20,20,20,20,20,20,21,21,21,21,21,21,21,21,21,21,21,21,21,21,21,21,21,21,21,21,21,21,21,21,21,21,22,22,22,22,22,22,22,22,22,22,22,22,22,22,22,22,22,22,22,22,22,22,22,22,22,22,22,22,22,22,0,0,0},
 {0,4,8,12,16,16,17,17,18,18,19,19,19,19,20,20,20,20,20,21,21,21,21,21,21,22,22,22,22,22,22,22,22,22,23,23,23,23,23,23,23,23,23,23,23,23,24,24,24,24,24,24,24,24,24,24,24,24,24,24,24,24,25,25,25,25,25,25,25,25,25,25,25,25,25,25,25,25,25,25,25,25,25,26,26,26,26,26,26,26,26,26,26,26,26,26,26,26,26,26,26,26,26,26,26,26,26,26,26,26,26,26,26,27,27,27,27,27,27,27,27,27,27,27,27,27,27,27,27,0,0,0},
 {0,16,18,19,20,21,21,22,22,23,23,23,24,24,24,24,25,25,25,25,25,26,26,26,26,26,26,26,26,27,27,27,27,27,27,27,27,27,27,28,28,28,28,28,28,28,28,28,28,28,28,28,29,29,29,29,29,29,29,29,29,29,29,29,29,29,29,29,29,29,30,30,30,30,30,30,30,30,30,30,30,30,30,30,30,30,30,30,30,30,30,30,30,30,30,31,31,31,31,31,31,31,31,31,31,31,31,31,31,31,31,31,31,31,31,31,31,31,31,31,31,31,31,31,31,31,31,31,31,0,0,0}};

namespace pg8 {
constexpr int BM = 256, BK = 64, HALF = 128, HTB = HALF * BK * 2, STAGE_BYTES = 8 * HTB, NXCD = 8, WGM = 8;
__host__ __device__ __forceinline__ int lds_byte(int r, int c) { const int st = (r >> 4) * 2 + (c >> 5), rr = r & 15, cc = c & 31, ob = rr * 64 + cc * 2; return st * 1024 + (ob ^ (((ob >> 9) & 1) << 5)); }
__host__ __device__ __forceinline__ void stage_rc(int b, int& R, int& C) { const int st = b / 1024, sb = b % 1024, swz = sb ^ (((sb >> 9) & 1) << 5); R = (st >> 1) * 16 + swz / 64; C = (st & 1) * 32 + (swz % 64) / 2; }
__host__ __device__ __forceinline__ int perm32(int rho) { const int n = rho >> 4, i = rho & 15; return 8 * (i >> 2) + 4 * n + (i & 3); }

struct Unit { int pm, pn, e, lt, slot; };
struct Gemm { const bf16* A; const bf16* Bt; int K; };

struct StaticOrder {
    int nM, nN, nwg, G, c;
    __host__ __device__ void init(int M, int N, int G_, int c_) { nM = M / BM; nN = N / BM; nwg = nM * nN; G = G_; c = c_; }
    __host__ __device__ bool next(int i, Unit& u) const {
        const long L = (long)i * G + c; if (L >= nwg) return false;
        int wgid = (int)L; { const int q = nwg / NXCD, r = nwg % NXCD, xcd = wgid % NXCD, off = wgid / NXCD; wgid = (xcd < r ? xcd * (q + 1) : r * (q + 1) + (xcd - r) * q) + off; }
        const int nig = WGM * nN, gid = wgid / nig, fm = gid * WGM, gsz = (nM - fm) < WGM ? (nM - fm) : WGM;
        u.pm = fm + ((wgid % nig) % gsz); u.pn = (wgid % nig) / gsz; u.e = 0; u.lt = 0; u.slot = i; return true;
    }
};
struct MoeOrder {
    const LAS int* tb; int G, c;
    __device__ __forceinline__ bool next(int i, Unit& u) const {
        const int L = i * G + c, NT = __builtin_amdgcn_readfirstlane(tb[32]);
        if (i >= MAXU || L >= NT * 8) return false;
        const int T = L >> 3, n = L & 7; int e = 0;
#pragma unroll
        for (int k = 1; k < 32; ++k) e += (tb[k] <= T) ? 1 : 0;
        e = __builtin_amdgcn_readfirstlane(e);
        u.pm = T; u.pn = e * 8 + n; u.e = e; u.lt = __builtin_amdgcn_readfirstlane(T - tb[e]); u.slot = i; return true;
    }
};

template <class Epi, class Sched, bool ALIGN_EPI, bool GATHER, bool F8 = false>
__device__ __forceinline__ void gemm_phase(LAS unsigned char* lds, const Gemm g, const Sched& S, const Epi& E, const LAS int* gtok, const int tid) {
    const int wid = __builtin_amdgcn_readfirstlane(tid >> 6), lane = tid & 63, wr = wid >> 2, wc = wid & 3, fr = lane & 15, fq = lane >> 4;
    const int K = g.K, nt = K / BK;
    const size_t kstep = (size_t)(BK * 2);
    const size_t hstep = (size_t)HALF * K * 2;
    const size_t tstep = 2 * hstep;
    unsigned voffB[2], vA[2][2];
#pragma unroll
    for (int i = 0; i < 2; ++i) { int R, C; stage_rc(tid * 16 + i * 8192, R, C); const int Rb = Epi::PERM ? ((R & ~31) + perm32(R & 31)) : R;
        voffB[i] = (unsigned)(Rb * K + C) * 2u;
        vA[0][i] = (unsigned)(R * K + C) * 2u; vA[1][i] = vA[0][i] + (unsigned)hstep; }
    const unsigned ldsw = (unsigned)wid * 1024u;
    const int aoff = lds_byte(wr * 64 + fr, fq * 8), boff = lds_byte(wc * 32 + fr, fq * 8);
#define PG8_SA(b, h) (((b) * 2 + (h)) * HTB)
#define PG8_SB(b, h) ((4 + (b) * 2 + (h)) * HTB)
#define PG8_STAGE(bufoff, gbase, voff) do { const char* _gb = (const char*)(gbase); asm volatile("" : "+s"(_gb)); _Pragma("unroll") for (int _i = 0; _i < 2; ++_i) { unsigned _vo = (voff)[_i]; asm volatile("" : "+v"(_vo)); \
        __builtin_amdgcn_global_load_lds((const unsigned*)(_gb + _vo), (LAS unsigned*)(lds + (bufoff) + ldsw + _i * 8192), 16, 0, 0); } } while (0)
#define PG8_GLOAD(v, slot_) do { const int _t = wid * 64 + lane_id_v(); _Pragma("unroll") for (int _i = 0; _i < 2; ++_i) { int _R, _C; stage_rc(_t * 16 + _i * 8192, _R, _C); \
        _Pragma("unroll") for (int _h = 0; _h < 2; ++_h) { int _tk = gtok[(slot_) * 256 + 128 * _h + _R]; _tk = _tk < 0 ? 0 : _tk; v[_h][_i] = (unsigned)(_tk * K + _C) * 2u; } } } while (0)
#define PG8_LDA(dst, b, h) do { if constexpr (F8) { _Pragma("unroll") for (int m = 0; m < 4; ++m) { const v4i _lo = *(const LAS v4i*)(lds + PG8_SA(b, h) + aoff + m * 2048), _hi = *(const LAS v4i*)(lds + PG8_SA(b, h) + aoff + m * 2048 + 1024); \
            dst##8[m] = __builtin_shufflevector(_lo, _hi, 0, 1, 2, 3, 4, 5, 6, 7); } } \
        else { _Pragma("unroll") for (int m = 0; m < 4; ++m) _Pragma("unroll") for (int k = 0; k < 2; ++k) dst[m][k] = *(const LAS bf16x8*)(lds + PG8_SA(b, h) + aoff + m * 2048 + k * 1024); } } while (0)
#define PG8_LDB(dst, b, h) do { if constexpr (F8) { _Pragma("unroll") for (int n = 0; n < 2; ++n) { const v4i _lo = *(const LAS v4i*)(lds + PG8_SB(b, h) + boff + n * 2048), _hi = *(const LAS v4i*)(lds + PG8_SB(b, h) + boff + n * 2048 + 1024); \
            dst##8[n] = __builtin_shufflevector(_lo, _hi, 0, 1, 2, 3, 4, 5, 6, 7); } } \
        else { _Pragma("unroll") for (int n = 0; n < 2; ++n) _Pragma("unroll") for (int k = 0; k < 2; ++k) dst[n][k] = *(const LAS bf16x8*)(lds + PG8_SB(b, h) + boff + n * 2048 + k * 1024); } } while (0)
#define PG8_MMA(ai, bj, At, Bt) do { __builtin_amdgcn_s_setprio(1); \
        if constexpr (F8) { _Pragma("unroll") for (int m = 0; m < 4; ++m) _Pragma("unroll") for (int n = 0; n < 2; ++n) \
            acc[ai][bj][m][n] = __builtin_amdgcn_mfma_scale_f32_16x16x128_f8f6f4(Bt##8[n], At##8[m], acc[ai][bj][m][n], 0, 0, 0, 0x7f7f7f7f, 0, 0x7f7f7f7f); } \
        else { _Pragma("unroll") for (int m = 0; m < 4; ++m) _Pragma("unroll") for (int n = 0; n < 2; ++n) _Pragma("unroll") for (int k = 0; k < 2; ++k) \
            acc[ai][bj][m][n] = __builtin_amdgcn_mfma_f32_16x16x32_bf16(Bt[n][k], At[m][k], acc[ai][bj][m][n], 0, 0, 0); } \
        __builtin_amdgcn_s_setprio(0); } while (0)
#define PG8_WAIT_V(n) asm volatile("s_waitcnt vmcnt(" #n ")" ::: "memory")
#define PG8_WAIT_L(n) asm volatile("s_waitcnt lgkmcnt(" #n ")" ::: "memory")
#define PG8_BAR __builtin_amdgcn_s_barrier()
#define PG8_SCHED __builtin_amdgcn_sched_barrier(0)
    Unit cur, nxt; int ui = 0;
    if (!S.next(0, cur)) return;
    f32x4 acc[2][2][4][2];
#pragma unroll
    for (int a = 0; a < 2; ++a)
#pragma unroll
        for (int b = 0; b < 2; ++b)
#pragma unroll
            for (int m = 0; m < 4; ++m)
#pragma unroll
                for (int n = 0; n < 2; ++n) acc[a][b][m][n] = (f32x4){0.f, 0.f, 0.f, 0.f};
    bf16x8 At[4][2], B0[2][2], B1[2][2]; v8i At8[4], B08[2], B18[2];
    const char* cA = GATHER ? (const char*)g.A : (const char*)g.A + (size_t)cur.pm * tstep; const char* cB = (const char*)g.Bt + (size_t)cur.pn * tstep;
    if constexpr (GATHER) { PG8_GLOAD(vA, cur.slot); }
    PG8_STAGE(PG8_SB(0, 0), cB, voffB); PG8_STAGE(PG8_SB(0, 1), cB + hstep, voffB); PG8_STAGE(PG8_SA(0, 0), cA, vA[0]); PG8_STAGE(PG8_SA(0, 1), cA, vA[1]);
    if (wr == 1) PG8_BAR;
    PG8_WAIT_V(2); PG8_BAR;
    PG8_STAGE(PG8_SB(1, 0), cB + kstep, voffB); PG8_STAGE(PG8_SA(1, 0), cA + kstep, vA[0]); PG8_STAGE(PG8_SB(1, 1), cB + hstep + kstep, voffB);
    PG8_WAIT_V(6); PG8_BAR;
    for (;;) {
        const bool has_next = S.next(ui + 1, nxt);
        const char* nA = GATHER ? cA : (has_next ? (const char*)g.A + (size_t)nxt.pm * tstep : cA); const char* nB = has_next ? (const char*)g.Bt + (size_t)nxt.pn * tstep : cB;

#pragma unroll 1
        for (int t = 0; t < nt; t += 2) {
            const bool last = (t == nt - 2);
            const char* a1 = cA + (size_t)(t + 1) * kstep;
            const char* a2 = last ? nA : cA + (size_t)(t + 2) * kstep; const char* b2 = last ? nB : cB + (size_t)(t + 2) * kstep;
            const char* a3 = a2 + kstep; const char* b3 = b2 + kstep;
            unsigned vS[2][2];
#pragma unroll
            for (int h = 0; h < 2; ++h)
#pragma unroll
                for (int i = 0; i < 2; ++i) vS[h][i] = vA[h][i];
            if constexpr (GATHER) { if (last && has_next) { PG8_GLOAD(vS, nxt.slot); } }

            PG8_LDB(B0, 0, 0); PG8_LDB(B1, 0, 1); PG8_SCHED; PG8_LDA(At, 0, 0); PG8_STAGE(PG8_SA(1, 1), a1, vA[1]);
            PG8_WAIT_V(8); PG8_WAIT_L(0); PG8_BAR; PG8_MMA(0, 0, At, B0); PG8_MMA(0, 1, At, B1); PG8_BAR; PG8_SCHED;
            PG8_LDA(At, 0, 1); PG8_STAGE(PG8_SB(0, 0), b2, voffB); PG8_STAGE(PG8_SB(0, 1), b2 + hstep, voffB); PG8_STAGE(PG8_SA(0, 0), a2, vS[0]);
            PG8_WAIT_V(8); PG8_WAIT_L(0); PG8_BAR; PG8_MMA(1, 0, At, B0); PG8_MMA(1, 1, At, B1); PG8_BAR; PG8_SCHED;
            PG8_LDB(B0, 1, 0); PG8_LDB(B1, 1, 1); PG8_SCHED; PG8_LDA(At, 1, 0); PG8_STAGE(PG8_SA(0, 1), a2, vS[1]);
            PG8_WAIT_V(8); PG8_WAIT_L(0); PG8_BAR; PG8_MMA(0, 0, At, B0); PG8_MMA(0, 1, At, B1); PG8_BAR; PG8_SCHED;
            PG8_LDA(At, 1, 1); PG8_STAGE(PG8_SB(1, 0), b3, voffB); PG8_STAGE(PG8_SB(1, 1), b3 + hstep, voffB); PG8_STAGE(PG8_SA(1, 0), a3, vS[0]);
            PG8_WAIT_V(8); PG8_WAIT_L(0); PG8_BAR; PG8_MMA(1, 0, At, B0); PG8_MMA(1, 1, At, B1); PG8_BAR; PG8_SCHED;
        }
        if constexpr (ALIGN_EPI) { if (wr == 0) PG8_BAR; }
        { const int _l = lane_id_v();
          E(acc, cur, wr, wc, _l & 15, _l >> 4); }
        if (!has_next) break;
#pragma unroll
        for (int a = 0; a < 2; ++a)
#pragma unroll
            for (int b = 0; b < 2; ++b)
#pragma unroll
                for (int m = 0; m < 4; ++m)
#pragma unroll
                    for (int n = 0; n < 2; ++n) acc[a][b][m][n] = (f32x4){0.f, 0.f, 0.f, 0.f};
        cur = nxt; cA = nA; cB = nB; ++ui;
        if constexpr (GATHER) { PG8_GLOAD(vA, cur.slot); }
        if constexpr (ALIGN_EPI) { if (wr == 1) PG8_BAR; }
    }
    PG8_WAIT_V(0);
    if constexpr (!ALIGN_EPI) { if (wr == 0) PG8_BAR; }
    PG8_BAR;
#undef PG8_SA
#undef PG8_SB
#undef PG8_STAGE
#undef PG8_GLOAD
#undef PG8_LDA
#undef PG8_LDB
#undef PG8_MMA
#undef PG8_WAIT_V
#undef PG8_WAIT_L
#undef PG8_BAR
#undef PG8_SCHED
}

typedef const f32x4 (&AccRef)[2][2][4][2];
struct EpiInProj {
    static constexpr bool PERM = true;
    bf16 *U, *Q, *Kb, *V; const float *qg, *kg;
    __device__ __forceinline__ void operator()(AccRef acc, const Unit& u, int wr, int wc, int fr, int fq) const {
        const int row0 = u.pm * BM + wr * 64 + fr;
        if (u.pn < 8) {
#pragma unroll
            for (int ai = 0; ai < 2; ++ai)
#pragma unroll
                for (int m = 0; m < 4; ++m) { const int r = row0 + ai * HALF + m * 16;
                    f32x4 a0 = acc[ai][0][m][0], a1 = acc[ai][0][m][1], g0 = acc[ai][1][m][0], g1 = acc[ai][1][m][1];
                    v4u w; w.x = cvt_pk_bf16(a0[0] * sigmoidf_(g0[0]), a0[1] * sigmoidf_(g0[1])); w.y = cvt_pk_bf16(a0[2] * sigmoidf_(g0[2]), a0[3] * sigmoidf_(g0[3]));
                    w.z = cvt_pk_bf16(a1[0] * sigmoidf_(g1[0]), a1[1] * sigmoidf_(g1[1])); w.w = cvt_pk_bf16(a1[2] * sigmoidf_(g1[2]), a1[3] * sigmoidf_(g1[3]));
                    *(v4u*)(U + (size_t)r * CCH + 128 * u.pn + 32 * wc + 8 * fq) = w; }
        } else if (u.pn < 16) {
            const int t = u.pn - 8, tensor = t >> 2, head = 4 * (t & 3) + wc;
            const float* gn = tensor ? kg : qg; bf16* dst = tensor ? Kb : Q; const float sc0 = tensor ? 1.f : C2;
            f32x4 gv[2][2];
#pragma unroll
            for (int bj = 0; bj < 2; ++bj)
#pragma unroll
                for (int n = 0; n < 2; ++n) gv[bj][n] = *(const f32x4*)(gn + 32 * bj + 8 * fq + 4 * n);
#pragma unroll
            for (int ai = 0; ai < 2; ++ai)
#pragma unroll
                for (int m = 0; m < 4; ++m) { const int r = row0 + ai * HALF + m * 16; float ss = 0.f;
#pragma unroll
                    for (int bj = 0; bj < 2; ++bj)
#pragma unroll
                        for (int n = 0; n < 2; ++n) { const f32x4 v = acc[ai][bj][m][n]; ss += (v[0] * v[0] + v[1] * v[1]) + (v[2] * v[2] + v[3] * v[3]); }
                    ss += __shfl_xor(ss, 16); ss += __shfl_xor(ss, 32);
                    const float sc = sc0 * __builtin_amdgcn_rsqf(ss * (1.f / 64.f) + NORM_EPS);
#pragma unroll
                    for (int bj = 0; bj < 2; ++bj) { const f32x4 v0 = acc[ai][bj][m][0] * gv[bj][0] * sc, v1 = acc[ai][bj][m][1] * gv[bj][1] * sc;
                        v4u w; w.x = cvt_pk_bf16(v0[0], v0[1]); w.y = cvt_pk_bf16(v0[2], v0[3]); w.z = cvt_pk_bf16(v1[0], v1[1]); w.w = cvt_pk_bf16(v1[2], v1[3]);
                        *(v4u*)(dst + (size_t)r * AW + 64 * head + 32 * bj + 8 * fq) = w; } }
        } else {
            const int cb = 256 * (u.pn - 16) + 32 * wc + 8 * fq;
#pragma unroll
            for (int ai = 0; ai < 2; ++ai)
#pragma unroll
                for (int m = 0; m < 4; ++m) { const int r = row0 + ai * HALF + m * 16;
#pragma unroll
                    for (int bj = 0; bj < 2; ++bj) { const f32x4 v0 = acc[ai][bj][m][0], v1 = acc[ai][bj][m][1];
                        v4u w; w.x = cvt_pk_bf16(v0[0], v0[1]); w.y = cvt_pk_bf16(v0[2], v0[3]); w.z = cvt_pk_bf16(v1[0], v1[1]); w.w = cvt_pk_bf16(v1[2], v1[3]);
                        *(v4u*)(V + (size_t)r * AW + cb + 128 * bj) = w; } }
        }
    }
};
struct EpiResF32 {
    static constexpr bool PERM = true;
    const float* X; float* O; bf16* HN; const float* g2;
    __device__ __forceinline__ void operator()(AccRef acc, const Unit& u, int wr, int wc, int fr, int fq) const {
        const int row0 = u.pm * BM + wr * 64 + fr, col0 = u.pn * BM + wc * 32 + 8 * fq;
        f32x4 gv[2][2];
#pragma unroll
        for (int bj = 0; bj < 2; ++bj)
#pragma unroll
            for (int n = 0; n < 2; ++n) gv[bj][n] = *(const f32x4*)(g2 + col0 + bj * HALF + 4 * n);
#pragma unroll
        for (int ai = 0; ai < 2; ++ai)
#pragma unroll
            for (int m = 0; m < 4; ++m) { const size_t ro = (size_t)(row0 + ai * HALF + m * 16) * DM + col0;
                f32x4 xv[2][2];
#pragma unroll
                for (int bj = 0; bj < 2; ++bj)
#pragma unroll
                    for (int n = 0; n < 2; ++n) xv[bj][n] = __builtin_nontemporal_load((const f32x4*)(X + ro + bj * HALF + 4 * n));
#pragma unroll
                for (int bj = 0; bj < 2; ++bj) { const f32x4 a = xv[bj][0] + acc[ai][bj][m][0], b = xv[bj][1] + acc[ai][bj][m][1];
                    *(f32x4*)(O + ro + bj * HALF) = a; *(f32x4*)(O + ro + bj * HALF + 4) = b;
                    const f32x4 ha = a * gv[bj][0], hb = b * gv[bj][1];
                    v2u w; w.x = pk4_fp8(ha[0], ha[1], ha[2], ha[3]); w.y = pk4_fp8(hb[0], hb[1], hb[2], hb[3]);
                    *(v2u*)((unsigned char*)HN + ro + bj * HALF) = w; } }
    }
};
struct EpiSwiGLU {
    static constexpr bool PERM = true;
    bf16* H; const LAS float* wts; const LAS float* rs;
    __device__ __forceinline__ void operator()(AccRef acc, const Unit& u, int wr, int wc, int fr, int fq) const {
        const int cb = 128 * (u.pn & 7) + 32 * wc + 8 * fq;
#pragma unroll
        for (int ai = 0; ai < 2; ++ai)
#pragma unroll
            for (int m = 0; m < 4; ++m) { const int R = ai * HALF + wr * 64 + m * 16 + fr; const float r = rs[u.slot * 256 + R] * (1.f / W8_SCALE), w = wts[u.slot * 256 + R] * r;
                const f32x4 g0 = acc[ai][0][m][0] * r, g1 = acc[ai][0][m][1] * r, u0 = acc[ai][1][m][0] * w, u1 = acc[ai][1][m][1] * w;
                v4u o; o.x = cvt_pk_bf16(g0[0] * sigmoidf_(g0[0]) * u0[0], g0[1] * sigmoidf_(g0[1]) * u0[1]); o.y = cvt_pk_bf16(g0[2] * sigmoidf_(g0[2]) * u0[2], g0[3] * sigmoidf_(g0[3]) * u0[3]);
                o.z = cvt_pk_bf16(g1[0] * sigmoidf_(g1[0]) * u1[0], g1[1] * sigmoidf_(g1[1]) * u1[1]); o.w = cvt_pk_bf16(g1[2] * sigmoidf_(g1[2]) * u1[2], g1[3] * sigmoidf_(g1[3]) * u1[3]);
                *(v4u*)(H + (size_t)(u.pm * BM + R) * DFF + cb) = o; }
    }
};
struct EpiYStore {
    static constexpr bool PERM = true;
    bf16* Y;
    __device__ __forceinline__ void operator()(AccRef acc, const Unit& u, int wr, int wc, int fr, int fq) const {
        const int cb = 256 * (u.pn & 7) + 32 * wc + 8 * fq;
#pragma unroll
        for (int ai = 0; ai < 2; ++ai)
#pragma unroll
            for (int m = 0; m < 4; ++m) { const int R = ai * HALF + wr * 64 + m * 16 + fr;
#pragma unroll
                for (int bj = 0; bj < 2; ++bj) { const f32x4 v0 = acc[ai][bj][m][0], v1 = acc[ai][bj][m][1];
                    v4u w; w.x = cvt_pk_bf16(v0[0], v0[1]); w.y = cvt_pk_bf16(v0[2], v0[3]); w.z = cvt_pk_bf16(v1[0], v1[1]); w.w = cvt_pk_bf16(v1[2], v1[3]);
                    *(v4u*)(Y + (size_t)(u.pm * BM + R) * DM + cb + 128 * bj) = w; } }
    }
};
struct EpiScatter {
    static constexpr bool PERM = false;
    float* O; const LAS int* toks;
    __device__ __forceinline__ void operator()(AccRef acc, const Unit& u, int wr, int wc, int fr, int fq) const {
        const int col0 = (u.pn & 7) * BM + wc * 32 + 4 * fq;
#pragma unroll
        for (int ai = 0; ai < 2; ++ai)
#pragma unroll
            for (int m = 0; m < 4; ++m) { const int R = ai * HALF + wr * 64 + m * 16 + fr; const int tok = toks[u.slot * 256 + R];
                if (tok >= 0) { float* ro = O + (size_t)tok * DM + col0;
#pragma unroll
                    for (int bj = 0; bj < 2; ++bj)
#pragma unroll
                        for (int n = 0; n < 2; ++n) { const f32x4 v = acc[ai][bj][m][n]; float* p = ro + bj * HALF + n * 16;
                            unsafeAtomicAdd(p + 0, v[0]); unsafeAtomicAdd(p + 1, v[1]); unsafeAtomicAdd(p + 2, v[2]); unsafeAtomicAdd(p + 3, v[3]); } } }
    }
};
}

#define XB_TMO      128
#define XB_XCNT(j)  (256  + 64 * (j))
#define XB_XSUB(j)  (1280 + 64 * (j))
#define XB_XGEN(j)  (2304 + 64 * (j))
#define XB_TOP      3328
#define XB_TOPGEN   3392
#define XCD_BAR_WORDS 3456
#define XB_SPIN_CAP (1u << 18)
__device__ __forceinline__ unsigned xb_ld(unsigned* p)              { return __hip_atomic_load(p, __ATOMIC_RELAXED, __HIP_MEMORY_SCOPE_AGENT); }
__device__ __forceinline__ unsigned xb_add(unsigned* p, unsigned v) { return __hip_atomic_fetch_add(p, v, __ATOMIC_RELAXED, __HIP_MEMORY_SCOPE_AGENT); }
__device__ __forceinline__ unsigned xb_xcc_id() { return (unsigned)__builtin_amdgcn_s_getreg((3 << 11) | 20) & 0xFu; }
#define XB_SPIN(cond, bar) do { unsigned _sp = 0; while (cond) { __builtin_amdgcn_s_sleep(1); \
    if ((++_sp & 255u) == 0u) { if (xb_ld(&(bar)[XB_TMO])) break; if (_sp > XB_SPIN_CAP) { atomicAdd(&(bar)[XB_TMO], 1u); break; } } } } while (0)
struct XcdBarrier { unsigned* bar; unsigned x; volatile LAS unsigned* st; };
__device__ __forceinline__ XcdBarrier xcd_barrier_post(unsigned* bar, volatile LAS unsigned* st, const int tid) {
    XcdBarrier b; b.bar = bar; b.x = xb_xcc_id(); b.st = st;
    if (tid == 0) (void)xb_add(&bar[XB_XCNT(b.x)], 1u);
    return b;
}
__device__ __forceinline__ void xcd_barrier_complete(unsigned* bar, unsigned x, unsigned& nloc, unsigned& nx) {
    const unsigned G = gridDim.x * gridDim.y * gridDim.z;
    unsigned sum, cnt, mine, sp = 0u;
    for (;;) {
        sum = 0u; cnt = 0u; mine = 0u;
#pragma unroll
        for (unsigned j = 0; j < 16; ++j) { const unsigned c = xb_ld(&bar[XB_XCNT(j)]); sum += c; cnt += (c > 0u) ? 1u : 0u; mine = (j == x) ? c : mine; }
        if (sum == G) break;
        __builtin_amdgcn_s_sleep(1);
        if ((++sp & 255u) == 0u) { if (xb_ld(&bar[XB_TMO])) break; if (sp > XB_SPIN_CAP) { atomicAdd(&bar[XB_TMO], 1u); break; } }
    }
    nloc = mine > 0u ? mine : 1u; nx = cnt > 0u ? cnt : 1u;
}
__device__ __forceinline__ void xcd_barrier(const XcdBarrier& b, const int tid) {
    asm volatile("s_waitcnt vmcnt(0)" ::: "memory");
    __syncthreads();
    if (tid == 0) {
        unsigned* bar = b.bar;
        __builtin_amdgcn_s_waitcnt(0);
        unsigned nloc = b.st[0], nx = b.st[1];
        if (nloc == 0u) { xcd_barrier_complete(bar, b.x, nloc, nx); b.st[0] = nloc; b.st[1] = nx; }
        const unsigned old = xb_add(&bar[XB_XSUB(b.x)], 1u);
        const unsigned gen = old / nloc;
        if (old + 1u == (gen + 1u) * nloc) {
            __builtin_amdgcn_fence(__ATOMIC_RELEASE, "agent");
            asm volatile("s_waitcnt vmcnt(0)" ::: "memory");
            const unsigned og = xb_add(&bar[XB_TOP], 1u);
            const unsigned tg = og / nx;
            if (og + 1u == (tg + 1u) * nx) xb_add(&bar[XB_TOPGEN], 1u);
            else XB_SPIN(xb_ld(&bar[XB_TOPGEN]) == tg, bar);
            __builtin_amdgcn_fence(__ATOMIC_ACQUIRE, "agent");
            xb_add(&bar[XB_XGEN(b.x)], 1u);
            asm volatile("s_waitcnt vmcnt(0)" ::: "memory");
        } else {
            XB_SPIN(xb_ld(&bar[XB_XGEN(b.x)]) == gen, bar);
            __builtin_amdgcn_fence(__ATOMIC_ACQUIRE, "agent");
            asm volatile("s_waitcnt vmcnt(0)" ::: "memory");
        }
    }
    __syncthreads();
}

struct Args {
    const float *x, *norm1_g, *w_in, *q_norm_g, *k_norm_g, *conv_w, *conv_b, *conv_ln_g, *conv_ln_b, *rel_bias, *w_out, *norm2_g, *w_rg, *b_rg, *w_re, *b_re, *w_gate, *w_up, *w_down;
    float* out; float* out_w; unsigned char* ws; int ph_lo, ph_hi;
};

__device__ __forceinline__ void transpose_item(const float* Wsrc, int ldw, bf16* dst, int ldd, LAS float* scr, int lane) {
    const float* p = Wsrc + (size_t)(lane >> 5) * ldw + (lane & 31);
#pragma unroll 1
    for (int hh = 0; hh < 2; ++hh) {
        float tv[16];
#pragma unroll
        for (int i = 0; i < 16; ++i) { tv[i] = *p; p += 2 * ldw; }
#pragma unroll
        for (int i = 0; i < 16; ++i) { const int kk = 2 * (16 * hh + i) + (lane >> 5); scr[kk * 33 + (lane & 31)] = tv[i]; }
    }
    LDS_WAIT(); asm volatile("" ::: "memory");
    const int c = lane & 7;
#pragma unroll
    for (int j = 0; j < 4; ++j) { const int n = (lane >> 3) + 8 * j; const LAS float* s = scr + (8 * c) * 33 + n;
        v4u o; o.x = pk2(s[0 * 33], s[1 * 33]); o.y = pk2(s[2 * 33], s[3 * 33]); o.z = pk2(s[4 * 33], s[5 * 33]); o.w = pk2(s[6 * 33], s[7 * 33]);
        *(GAS v4u*)(dst + (size_t)n * ldd + 8 * c) = o; }
    LDS_WAIT(); asm volatile("" ::: "memory");
}
__device__ __forceinline__ void t64_load(const float* Wsrc, int ldw, int lane, f32x4 (&tv)[16]) {
    const float* p = Wsrc + (size_t)(lane >> 3) * ldw + 4 * (lane & 7);
#pragma unroll
    for (int i = 0; i < 16; ++i) { tv[i] = __builtin_nontemporal_load((const f32x4*)p); p += 8 * ldw; }
}
__device__ __forceinline__ void t64_finish(const f32x4 (&tv)[16], unsigned char* dst, int ldd, int f8, LAS unsigned char* scr, int lane) {
    const int g = lane >> 4, i16 = lane & 15;
#pragma unroll
    for (int i = 0; i < 16; ++i) { v2u w; w.x = cvt_pk_bf16(tv[i].x, tv[i].y); w.y = cvt_pk_bf16(tv[i].z, tv[i].w); *(LAS v2u*)(scr + (8 * i + (lane >> 3)) * 64 + 8 * (lane & 7)) = w; }
    LDS_WAIT(); asm volatile("" ::: "memory");
    const int q = i16 >> 2, pp = i16 & 3;
    bf16x8 o[8];
#pragma unroll
    for (int jj = 0; jj < 8; ++jj) { const int c = 4 * jj + g, nb = c & 1, kg = c >> 1;
        LAS unsigned char* ra = scr + (8 * kg + q) * 64 + 32 * nb + 8 * pp;
        const s16x4 lo = __builtin_bit_cast(s16x4, __builtin_amdgcn_ds_read_tr16_b64_v4i16((LAS s16x4*)ra));
        const s16x4 hi = __builtin_bit_cast(s16x4, __builtin_amdgcn_ds_read_tr16_b64_v4i16((LAS s16x4*)(ra + 4 * 64)));
        o[jj] = __builtin_shufflevector(lo, hi, 0, 1, 2, 3, 4, 5, 6, 7); }
    LDS_WAIT(); asm volatile("" ::: "memory");
#pragma unroll
    for (int jj = 0; jj < 8; ++jj) { const int c = 4 * jj + g, nb = c & 1, kg = c >> 1; const int n = 16 * nb + i16;
        *(LAS bf16x8*)(scr + n * 256 + 16 * (kg ^ (n & 15))) = o[jj]; }
    LDS_WAIT(); asm volatile("" ::: "memory");
    const int rr = lane >> 3, cc = lane & 7;
#pragma unroll
    for (int it = 0; it < 4; ++it) { const int n = 8 * it + rr;
        const v4u v0 = *(const LAS v4u*)(scr + n * 256 + 16 * ((2 * cc) ^ (n & 15))), v1 = *(const LAS v4u*)(scr + n * 256 + 16 * ((2 * cc + 1) ^ (n & 15)));
        if (f8) { v4u o4; o4.x = pk4_fp8(bf_lo(v0.x) * W8_SCALE, bf_hi(v0.x) * W8_SCALE, bf_lo(v0.y) * W8_SCALE, bf_hi(v0.y) * W8_SCALE);
            o4.y = pk4_fp8(bf_lo(v0.z) * W8_SCALE, bf_hi(v0.z) * W8_SCALE, bf_lo(v0.w) * W8_SCALE, bf_hi(v0.w) * W8_SCALE);
            o4.z = pk4_fp8(bf_lo(v1.x) * W8_SCALE, bf_hi(v1.x) * W8_SCALE, bf_lo(v1.y) * W8_SCALE, bf_hi(v1.y) * W8_SCALE);
            o4.w = pk4_fp8(bf_lo(v1.z) * W8_SCALE, bf_hi(v1.z) * W8_SCALE, bf_lo(v1.w) * W8_SCALE, bf_hi(v1.w) * W8_SCALE);
            __builtin_nontemporal_store(o4, (GAS v4u*)(dst + (size_t)n * ldd + 16 * cc)); }
        else { *(GAS v4u*)(dst + (size_t)n * ldd + 32 * cc) = v0; *(GAS v4u*)(dst + (size_t)n * ldd + 32 * cc + 16) = v1; } }
    LDS_WAIT(); asm volatile("" ::: "memory");
}
__device__ __forceinline__ int win_src_col(int n0) {
    const int pn = n0 >> 8, j = n0 & 255;
    if (pn < 8) return ((j >> 7) ? CCH : 0) + 128 * pn + (j & 127);
    if (pn < 16) { const int t = pn - 8, tensor = t >> 2, head = 4 * (t & 3) + ((j >> 5) & 3), dim = 32 * (j >> 7); return 2 * CCH + AW * tensor + 64 * head + dim; }
    return 2 * CCH + 2 * AW + 256 * (pn - 16) + j;
}
__device__ __forceinline__ void rms_row_to_bf16(const float* xrow, const float* g, bf16* orow, int lane) {
    const GAS f32x4* xr = (const GAS f32x4*)xrow + lane; const GAS f32x4* gr = (const GAS f32x4*)g + lane;
    f32x4 v[8]; float s = 0.f;
#pragma unroll
    for (int j = 0; j < 8; ++j) { v[j] = xr[64 * j]; s += (v[j].x * v[j].x + v[j].y * v[j].y) + (v[j].z * v[j].z + v[j].w * v[j].w); }
    const float rstd = __builtin_amdgcn_rsqf(wave_sum(s) * (1.f / DM) + NORM_EPS);
    GAS v2u* o8 = (GAS v2u*)orow + lane;
#pragma unroll
    for (int j = 0; j < 8; ++j) { const f32x4 gg = gr[64 * j]; v2u w; w.x = pk2(v[j].x * rstd * gg.x, v[j].y * rstd * gg.y); w.y = pk2(v[j].z * rstd * gg.z, v[j].w * rstd * gg.w); o8[64 * j] = w; }
}

template <int P, int NT>
__device__ __forceinline__ void attn_pattern(const bf16* __restrict__ Kh, const bf16* __restrict__ Vh, const int t0, LAS unsigned char* vbuf, const LAS float* bt,
                                             const bf16x8 (&qf)[NT][2], f32x4 (&o)[NT][4], f32x4 (&lacc)[NT], int lane) {
    constexpr int DL = (P == 0) ? 1 : (P == 1) ? 4 : 16, SQ = 16 / DL, GS = 3, NGRPS = (P == 0) ? 4 : 2;
    constexpr int SH = 8 / DL;
    static_assert(NT == 1 || P < 2, "tile pairs share keys only for dilation 1 and 4");
    const int qi = lane & 15, g = lane >> 4, q4 = qi >> 2, pp = qi & 3;
    const int xr = (2 * g + (q4 >> 1)) & 3;
    unsigned tra[4];
#pragma unroll
    for (int dt = 0; dt < 4; ++dt) tra[dt] = (unsigned)((4 * g + q4) * 128 + 32 * (dt ^ xr) + 8 * pp);
    unsigned klo[2], vlo[4], vwa[4];
#pragma unroll
    for (int tt = 0; tt < 2; ++tt) klo[tt] = (unsigned)(DL * (16 * tt + qi) * AW + 8 * g);
#pragma unroll
    for (int k = 0; k < 4; ++k) { const int idx = lane + 64 * k, row = idx >> 3, c16 = idx & 7; vlo[k] = (unsigned)(DL * row * AW + 8 * c16); vwa[k] = (unsigned)(row * 128 + 16 * (c16 ^ (((row >> 1) & 3) << 1))); }
    const int tq = t0 / DL;
    unsigned relmax[NT];
#pragma unroll
    for (int x = 0; x < NT; ++x) { const int m = SQ * qi + tq + x * SH; relmax[x] = (unsigned)(m < 128 ? m : 128); }
    const int relb = 128 + SQ * qi - 4 * g;
    const bf16x8 ones = (bf16x8){0x3f80, 0x3f80, 0x3f80, 0x3f80, 0x3f80, 0x3f80, 0x3f80, 0x3f80};
#pragma unroll 1
    for (int grp = 0; grp < NGRPS; ++grp) {
        bf16x8 kfg[GS][2][2]; v4u vrg[GS][4];
#pragma unroll
        for (int s3 = 0; s3 < GS; ++s3) { if (P == 2 && GS * grp + s3 >= 5) break;
            const long ro = ((long)t0 + DL * (32 * (GS * grp + s3) - 128)) * AW; const bf16* kb = Kh + ro; const bf16* vbs = Vh + ro;
#pragma unroll
            for (int tt = 0; tt < 2; ++tt) { kfg[s3][tt][0] = *(const bf16x8*)(kb + klo[tt]); kfg[s3][tt][1] = *(const bf16x8*)(kb + klo[tt] + 32); }
#pragma unroll
            for (int k = 0; k < 4; ++k) vrg[s3][k] = *(const v4u*)(vbs + vlo[k]); }
#pragma unroll
        for (int s3 = 0; s3 < GS; ++s3) {
            const int c = GS * grp + s3;
            if (P == 2 && c >= 5) break;
            LAS unsigned char* vb = vbuf + s3 * 4096;
#pragma unroll
            for (int k = 0; k < 4; ++k) *(LAS v4u*)(vb + vwa[k]) = vrg[s3][k];
            const int rel0 = relb - 32 * c;
            bf16x8 pf[NT];
#pragma unroll
            for (int x = 0; x < NT; ++x) {
                f32x4 sc[2];
#pragma unroll
                for (int tt = 0; tt < 2; ++tt) { f32x4 z = (f32x4){0.f, 0.f, 0.f, 0.f};
                    z = __builtin_amdgcn_mfma_f32_16x16x32_bf16(kfg[s3][tt][0], qf[x][0], z, 0, 0, 0);
                    sc[tt] = __builtin_amdgcn_mfma_f32_16x16x32_bf16(kfg[s3][tt][1], qf[x][1], z, 0, 0, 0); }
                const LAS float* btp = bt + (rel0 + x * SH - 19);
                float p[2][4];
#pragma unroll
                for (int tt = 0; tt < 2; ++tt)
#pragma unroll
                    for (int e = 0; e < 4; ++e) { const int rel = rel0 + x * SH - 16 * tt - e;
                        const float pe = __builtin_amdgcn_exp2f(sc[tt][e] + btp[19 - 16 * tt - e]);
                        p[tt][e] = ((unsigned)rel <= relmax[x]) ? pe : 0.f; }
                v4u pw; pw.x = cvt_pk_s(p[0][0], p[0][1]); pw.y = cvt_pk_s(p[0][2], p[0][3]); pw.z = cvt_pk_s(p[1][0], p[1][1]); pw.w = cvt_pk_s(p[1][2], p[1][3]);
                pf[x] = __builtin_bit_cast(bf16x8, pw);
                lacc[x] = __builtin_amdgcn_mfma_f32_16x16x32_bf16(ones, pf[x], lacc[x], 0, 0, 0);
            }
#pragma unroll
            for (int dt = 0; dt < 4; ++dt) {
                const s16x4 lo = __builtin_bit_cast(s16x4, __builtin_amdgcn_ds_read_tr16_b64_v4i16((LAS s16x4*)(vb + tra[dt])));
                const s16x4 hi = __builtin_bit_cast(s16x4, __builtin_amdgcn_ds_read_tr16_b64_v4i16((LAS s16x4*)(vb + tra[dt] + 2048)));
                const bf16x8 vf = __builtin_shufflevector(lo, hi, 0, 1, 2, 3, 4, 5, 6, 7);
#pragma unroll
                for (int x = 0; x < NT; ++x) o[x][dt] = __builtin_amdgcn_mfma_f32_16x16x32_bf16(vf, pf[x], o[x][dt], 0, 0, 0);
            }
        }
    }
}

__device__ __forceinline__ void attn_wave(const bf16* Q, const bf16* Kb, const bf16* Vb, bf16* MIX, int h, const int t0, LAS unsigned char* vbuf, const LAS float* bt, int lane) {
    asm volatile("" : "+v"(lane));
    const int qi = lane & 15, g = lane >> 4;
    bf16x8 qf[2][2]; f32x4 o[2][4]; f32x4 lacc[2];
#pragma unroll
    for (int x = 0; x < 2; ++x) { const bf16* qrow = Q + (size_t)(t0 + 8 * x + 16 * qi) * AW + 64 * h + 8 * g; qf[x][0] = *(const bf16x8*)qrow; qf[x][1] = *(const bf16x8*)(qrow + 32);
        lacc[x] = (f32x4){0.f, 0.f, 0.f, 0.f};
#pragma unroll
        for (int dt = 0; dt < 4; ++dt) o[x][dt] = (f32x4){0.f, 0.f, 0.f, 0.f}; }
    const bf16* Kh = Kb + 64 * h; const bf16* Vh = Vb + 64 * h;
    attn_pattern<0, 2>(Kh, Vh, t0, vbuf, bt, qf, o, lacc, lane);
    attn_pattern<1, 2>(Kh, Vh, t0, vbuf, bt + 132, qf, o, lacc, lane);
#pragma unroll
    for (int x = 0; x < 2; ++x) {
        bf16x8 q1[1][2] = {{qf[x][0], qf[x][1]}}; f32x4 o1[1][4] = {{o[x][0], o[x][1], o[x][2], o[x][3]}}; f32x4 l1[1] = {lacc[x]};
        attn_pattern<2, 1>(Kh, Vh, t0 + 8 * x, vbuf, bt + 264, q1, o1, l1, lane);
        const float inv = 1.f / l1[0][0];
        bf16* orow = MIX + (size_t)(t0 + 8 * x + 16 * qi) * DM + CCH + 64 * h + 4 * g;
#pragma unroll
        for (int dt = 0; dt < 4; ++dt) { v2u w; w.x = cvt_pk_bf16(o1[0][dt][0] * inv, o1[0][dt][1] * inv); w.y = cvt_pk_bf16(o1[0][dt][2] * inv, o1[0][dt][3] * inv); *(v2u*)(orow + 16 * dt) = w; }
    }
}

constexpr int CV_IN = (DM / 64) * (INW / 32), CV_OUT = (DM / 64) * (DM / 32), CV_GU = NEXP * 2 * (DM / 128) * (DFF / 32), CV_D = NEXP * (DFF / 128) * (DM / 32);
constexpr int CV_SMALL = CV_IN + CV_OUT, CV_ALL = CV_SMALL + CV_GU + CV_D;
constexpr int P1_ROUNDS = 4;
constexpr int CV_N1 = 28672, CV_N5 = 4096;
__device__ __forceinline__ void convert_item(const float* w_in, const float* w_out, int r, bf16* BTIN, bf16* BTOUT, LAS float* scr, int lane) {
    if (r < CV_IN) { const int nblk = INW / 32, kb = r / nblk, nb = r % nblk; transpose_item(w_in + (size_t)(64 * kb) * INW + win_src_col(32 * nb), INW, BTIN + (size_t)(32 * nb) * DM + 64 * kb, DM, scr, lane); return; }
    r -= CV_IN;
    { const int nblk = DM / 32, kb = r / nblk, nb = r % nblk; transpose_item(w_out + (size_t)(64 * kb) * DM + 32 * nb, DM, BTOUT + (size_t)(32 * nb) * DM + 64 * kb, DM, scr, lane); }
}
struct XItem { const float* src; unsigned char* dst; int ldw, ldd, f8; };
__device__ __forceinline__ XItem xitem(const float* w_gate, const float* w_up, const float* w_down, bf16* BTGU, bf16* BTD, int r) {
    XItem it;
    if (r < CV_GU) { const int per = (DM / 128) * (DFF / 32); const int e = r / (2 * per), r2 = r % (2 * per), which = r2 / per, r3 = r2 % per; const int nblk = DFF / 32, kb = r3 / nblk, nb = r3 % nblk;
        const float* W = (which ? w_up : w_gate) + (size_t)e * DM * DFF;
        const int f0 = 32 * nb, brow = 256 * (f0 >> 7) + 128 * which + (f0 & 127);
        it.src = W + (size_t)(128 * kb) * DFF + f0; it.ldw = DFF; it.dst = (unsigned char*)BTGU + ((size_t)e * 2048 + brow) * DM + 128 * kb; it.ldd = DM; it.f8 = 1; return it; }
    r -= CV_GU;
    { const int per = (DFF / 128) * (DM / 32); const int e = r / per, r3 = r % per; const int nblk = DM / 32, kb = r3 / nblk, nb = r3 % nblk;
        it.src = w_down + (size_t)e * DFF * DM + (size_t)(128 * kb) * DM + 32 * nb; it.ldw = DM; it.dst = (unsigned char*)BTD + (((size_t)e * DM + 32 * nb) * DFF + 128 * kb) * 2; it.ldd = DFF * 2; it.f8 = 0; return it; }
}
__device__ __forceinline__ void convert_range(const float* w_gate, const float* w_up, const float* w_down, bf16* BTGU, bf16* BTD, int x0, int x1, LAS unsigned char* scr, int lane) {
    if (x0 >= x1) return;
    f32x4 ta[16], tc[16];
    XItem A = xitem(w_gate, w_up, w_down, BTGU, BTD, x0), B = A;
    t64_load(A.src, A.ldw, lane, ta);
#pragma unroll 1
    for (int x = x0; x < x1; x += 2) {
        const bool hasB = x + 1 < x1;
        if (hasB) { B = xitem(w_gate, w_up, w_down, BTGU, BTD, x + 1); t64_load(B.src, B.ldw, lane, tc); }
        t64_finish(ta, A.dst, A.ldd, A.f8, scr, lane);
        if (hasB) {
            if (x + 2 < x1) { A = xitem(w_gate, w_up, w_down, BTGU, BTD, x + 2); t64_load(A.src, A.ldw, lane, ta); }
            t64_finish(tc, B.dst, B.ldd, B.f8, scr, lane);
        }
    }
}

__global__ void __launch_bounds__(512, 2) hymba_fwd(Args args) {
    extern __shared__ __attribute__((aligned(16))) unsigned char lds_raw[];
    LAS unsigned char* lds = (LAS unsigned char*)lds_raw;
    const int wave = __builtin_amdgcn_readfirstlane(threadIdx.x >> 6);
#define TID() (wave * 64 + lane_id_v())
    const int G = gridDim.x, bx = blockIdx.x;
    unsigned char* ws = args.ws;
    gu32* ctl = (gu32*)(ws + WS_CTL);
    int* ltok = (int*)(ws + WS_LTOK); float* lw = (float*)(ws + WS_LW);
    bf16* BTIN = (bf16*)(ws + WS_BTIN); bf16* BTOUT = (bf16*)(ws + WS_BTOUT); bf16* XN = (bf16*)(ws + WS_XN); bf16* Ub = (bf16*)(ws + WS_U);
    bf16* Qb = (bf16*)(ws + WS_Q); bf16* Kb = (bf16*)(ws + WS_K); bf16* Vb = (bf16*)(ws + WS_V); bf16* MIX = (bf16*)(ws + WS_MIX); bf16* Hb = (bf16*)(ws + WS_H);
    bf16* BTGU = (bf16*)(ws + WS_BTGU); bf16* BTD = (bf16*)(ws + WS_BTD); bf16* Yb = (bf16*)(ws + WS_Y);
    volatile LAS unsigned* MISC = (volatile LAS unsigned*)(lds + MISC_OFF);
    { const int tid = TID(); if (tid < 16) MISC[tid] = 0u; }
    __syncthreads();
    XcdBarrier bar; bar.bar = (unsigned*)(ctl + CW_BAR); bar.x = 0; bar.st = nullptr;
    if (N_LAUNCHES == 1) bar = xcd_barrier_post((unsigned*)(ctl + CW_BAR), MISC, TID());
    const int lo = args.ph_lo, hi = args.ph_hi;
#define IN(k) (lo <= (k) && (k) < hi)
#define BOTH(k) (IN(k) && IN((k) + 1))
#define GRID_BAR() xcd_barrier(bar, TID())
    const int gw = bx * 8 + wave, NGW = G * 8;

    if (IN(0)) {
        const int lane = lane_id_v();
        LAS float* scr = (LAS float*)(lds + wave * 16384);
        for (int it = gw; it < CV_SMALL; it += NGW) convert_item(args.w_in, args.w_out, it, BTIN, BTOUT, scr, lane);
        for (int m = gw; m < SEQ; m += NGW) rms_row_to_bf16(args.x + (size_t)m * DM, args.norm1_g, XN + (size_t)m * DM, lane);
        {
            bf16* WRH = (bf16*)(ws + WS_WRH); bf16* WRL = (bf16*)(ws + WS_WRL);
            for (int idx = gw * 64 + lane; idx < 48 * DM; idx += NGW * 64) { const int j = idx / DM, d = idx % DM;
                float w = 0.f;
                if (j < 4) w = args.w_rg[d * NGRP + j]; else if (j < 36) w = args.w_re[((size_t)((j - 4) >> 3) * DM + d) * EPG + ((j - 4) & 7)];
                w *= args.norm2_g[d];
                const unsigned hi = f2bf(w); const float rem = w - __builtin_bit_cast(float, hi << 16);
                WRH[idx] = (bf16)hi; WRL[idx] = (bf16)f2bf(rem); }
        }
        if (BOTH(0)) GRID_BAR();
    }

    if (IN(1)) {
        const int units = (SEQ / 256) * (INW / 256), GG = (G >= 256) ? (units + P1_ROUNDS - 1) / P1_ROUNDS : G, FB = G - GG;
        if (bx < GG) {
            pg8::Gemm g{XN, BTIN, DM}; pg8::StaticOrder S; S.init(SEQ, INW, GG, bx);
            pg8::EpiInProj E{Ub, Qb, Kb, Vb, args.q_norm_g, args.k_norm_g};
            pg8::gemm_phase<pg8::EpiInProj, pg8::StaticOrder, true, false>(lds, g, S, E, nullptr, TID());
        }
        {   const int lane = lane_id_v();
            const int nb = FB > 0 ? FB : G, ti = FB > 0 ? bx - GG : bx;
            if (ti >= 0) { const int q = (CV_N1 + nb * 8 - 1) / (nb * 8), x0 = (ti * 8 + wave) * q, x1 = (x0 + q < CV_N1) ? x0 + q : CV_N1;
                convert_range(args.w_gate, args.w_up, args.w_down, BTGU, BTD, x0, x1, lds + wave * 8448, lane); }
        }
        if (BOTH(1)) GRID_BAR();
    }

    if (IN(2)) {
        LAS float* btab = (LAS float*)(lds + 8 * 12288);
        const int tid = TID(), lane = tid & 63;
        {
            float mq = 0.f, mk = 0.f;
            for (int d = 0; d < HD; ++d) { mq = fmaxf(mq, fabsf(args.q_norm_g[d])); mk = fmaxf(mk, fabsf(args.k_norm_g[d])); }
            for (int idx = tid; idx < NH * 3 * 132; idx += 512) { const int h = idx / 396, r2 = idx % 396, p = r2 / 132, rel = r2 % 132;
                float mb = 0.f; for (int b = 0; b < 32; ++b) mb = fmaxf(mb, fabsf(args.rel_bias[b * NH + h]));
                const float Mh = 1.02f * C2 * 64.f * mq * mk + mb * LOG2E;
                btab[idx] = args.rel_bias[(int)kBucket[p][rel] * NH + h] * LOG2E - Mh; }
        }
        __syncthreads();
        LAS unsigned char* vbuf = lds + wave * 12288;
        {
            constexpr int CV_LO = CV_N1, CV_HI = CV_GU + CV_D - CV_N5, CV_EXP = CV_HI - CV_LO;
            const int nA = (512 - bx + G - 1) / G;
            const int per_wave = (CV_EXP + NGW - 1) / NGW;
            const int c_lo = CV_LO + gw * per_wave, c_hi = (c_lo + per_wave < CV_HI) ? c_lo + per_wave : CV_HI;
            const int nsteps = nA > 0 ? nA : 1, per_batch = (per_wave + nsteps - 1) / nsteps;
            int ia = 0, ic = c_lo;
#pragma unroll 1
            for (int hs = 0; hs < 2 * nsteps; ++hs) {
                const bool doA = (((hs & 1) == 0) == (wave < 4));
                if (doA) { if (ia < nA) { const int a = bx + ia * G; const int blk = a >> 4, h = a & 15;
                        attn_wave(Qb, Kb, Vb, MIX, h, 256 * blk + wave, vbuf, btab + h * 396, lane); ++ia; } }
                else { const int ce = (ic + per_batch < c_hi) ? ic + per_batch : c_hi;
                    convert_range(args.w_gate, args.w_up, args.w_down, BTGU, BTD, ic, ce, vbuf, lane); ic = ce > ic ? ce : ic; }
            }
            convert_range(args.w_gate, args.w_up, args.w_down, BTGU, BTD, ic, c_hi, vbuf, lane);
        }
        __syncthreads();
        LAS float* cv = (LAS float*)lds;
        for (int ct = bx; ct < SEQ / 32; ct += G) {
            const int tb0 = 32 * ct, c0 = 2 * tid;
            float w0[CONVW], w1[CONVW];
#pragma unroll
            for (int j = 0; j < CONVW; ++j) { const f32x2 w = *(const f32x2*)(args.conv_w + j * CCH + c0); w0[j] = w.x; w1[j] = w.y; }
            const f32x2 cb = *(const f32x2*)(args.conv_b + c0);
            unsigned uw[62];
#pragma unroll
            for (int i = 0; i < 62; ++i) { const int tr = tb0 - 30 + i; uw[i] = (tr >= 0) ? *(const unsigned*)(Ub + (size_t)tr * CCH + c0) : 0u; }
#pragma unroll
            for (int i = 0; i < 32; ++i) { float a0 = cb.x, a1 = cb.y;
#pragma unroll
                for (int j = 0; j < CONVW; ++j) { a0 += w0[j] * bf_lo(uw[i + j]); a1 += w1[j] * bf_hi(uw[i + j]); }
                *(LAS f32x2*)(cv + i * CCH + c0) = (f32x2){a0, a1}; }
            __syncthreads();
#pragma unroll 1
            for (int i = wave; i < 32; i += 8) {
                f32x4 v[4]; float s = 0.f;
#pragma unroll
                for (int k = 0; k < 4; ++k) { v[k] = *(const LAS f32x4*)(cv + i * CCH + 4 * lane + 256 * k); s += (v[k].x + v[k].y) + (v[k].z + v[k].w); }
                const float mean = wave_sum(s) * (1.f / CCH); float s2 = 0.f;
#pragma unroll
                for (int k = 0; k < 4; ++k) { v[k] = v[k] - mean; s2 += (v[k].x * v[k].x + v[k].y * v[k].y) + (v[k].z * v[k].z + v[k].w * v[k].w); }
                const float rstd = __builtin_amdgcn_rsqf(wave_sum(s2) * (1.f / CCH) + NORM_EPS);
                bf16* orow = MIX + (size_t)(tb0 + i) * DM;
#pragma unroll
                for (int k = 0; k < 4; ++k) { const int c = 4 * lane + 256 * k; const f32x4 gg = *(const f32x4*)(args.conv_ln_g + c), bb = *(const f32x4*)(args.conv_ln_b + c);
                    f32x4 y = v[k] * rstd * gg + bb; y.x *= sigmoidf_(y.x); y.y *= sigmoidf_(y.y); y.z *= sigmoidf_(y.z); y.w *= sigmoidf_(y.w);
                    v2u w; w.x = pk2(y.x, y.y); w.y = pk2(y.z, y.w); *(v2u*)(orow + c) = w; }
            }
            __syncthreads();
        }
        if (BOTH(2)) GRID_BAR();
    }

    if (IN(3)) {
        pg8::Gemm g{MIX, BTOUT, DM}; pg8::StaticOrder S; S.init(SEQ, DM, G, bx);
        pg8::EpiResF32 E{args.x, args.out, XN, args.norm2_g};
        pg8::gemm_phase<pg8::EpiResF32, pg8::StaticOrder, true, false>(lds, g, S, E, nullptr, TID());
        if (BOTH(3)) GRID_BAR();
    }

    if (IN(4)) {
        const int tid = TID(), lane = tid & 63, li = lane & 15, kg = lane >> 4;
        LAS float* part = (LAS float*)lds;
        LAS float* logit = (LAS float*)(lds + 49152);
        LAS float* ssp = (LAS float*)(lds + 49152 + 6144);
        LAS float* rsl = ssp + 256;
        LAS int* selE = (LAS int*)(rsl + 32); LAS float* selW = (LAS float*)(selE + 64);
        int* tokpos = (int*)(ws + WS_TOKPOS); float* rstd_g = (float*)(ws + WS_RSTD);
        const bf16* WRH = (const bf16*)(ws + WS_WRH); const bf16* WRL = (const bf16*)(ws + WS_WRL);
        constexpr int NTILE = SEQ / 32;
        for (int tile = bx; tile < NTILE; tile += G) {
            const int t0 = 32 * tile;
            {
                const float* xp = args.out + (size_t)(t0 + li) * DM + 256 * wave + 8 * kg;
                const bf16* hp = WRH + (size_t)li * DM + 256 * wave + 8 * kg; const bf16* lp = WRL + (size_t)li * DM + 256 * wave + 8 * kg;
                f32x4 acc[2][3]; float ss[2] = {0.f, 0.f};
#pragma unroll
                for (int x = 0; x < 2; ++x)
#pragma unroll
                    for (int nt = 0; nt < 3; ++nt) acc[x][nt] = (f32x4){0.f, 0.f, 0.f, 0.f};
#pragma unroll 1
                for (int hf = 0; hf < 2; ++hf) {
                    f32x4 xa[2][4][2]; bf16x8 bh[4][3], bl[4][3];
#pragma unroll
                    for (int s4 = 0; s4 < 4; ++s4) { const int ko = 32 * (4 * hf + s4);
#pragma unroll
                        for (int x = 0; x < 2; ++x) { xa[x][s4][0] = *(const f32x4*)(xp + (size_t)(16 * x) * DM + ko); xa[x][s4][1] = *(const f32x4*)(xp + (size_t)(16 * x) * DM + ko + 4); }
#pragma unroll
                        for (int nt = 0; nt < 3; ++nt) { bh[s4][nt] = *(const bf16x8*)(hp + (size_t)(16 * nt) * DM + ko); bl[s4][nt] = *(const bf16x8*)(lp + (size_t)(16 * nt) * DM + ko); } }
                    asm volatile("s_waitcnt vmcnt(0)" ::: "memory"); __builtin_amdgcn_sched_barrier(0);
#pragma unroll
                    for (int s4 = 0; s4 < 4; ++s4)
#pragma unroll
                        for (int x = 0; x < 2; ++x) { const f32x4 a = xa[x][s4][0], b = xa[x][s4][1];
                            ss[x] += (a.x * a.x + a.y * a.y) + (a.z * a.z + a.w * a.w) + (b.x * b.x + b.y * b.y) + (b.z * b.z + b.w * b.w);
                            v4u h; h.x = cvt_pk_s(a.x, a.y); h.y = cvt_pk_s(a.z, a.w); h.z = cvt_pk_s(b.x, b.y); h.w = cvt_pk_s(b.z, b.w);
                            v4u l; l.x = cvt_pk_s(a.x - bf_lo(h.x), a.y - bf_hi(h.x)); l.y = cvt_pk_s(a.z - bf_lo(h.y), a.w - bf_hi(h.y));
                            l.z = cvt_pk_s(b.x - bf_lo(h.z), b.y - bf_hi(h.z)); l.w = cvt_pk_s(b.z - bf_lo(h.w), b.w - bf_hi(h.w));
                            const bf16x8 xh = __builtin_bit_cast(bf16x8, h), xl = __builtin_bit_cast(bf16x8, l);
#pragma unroll
                            for (int nt = 0; nt < 3; ++nt) {
                                acc[x][nt] = __builtin_amdgcn_mfma_f32_16x16x32_bf16(xl, bl[s4][nt], acc[x][nt], 0, 0, 0);
                                acc[x][nt] = __builtin_amdgcn_mfma_f32_16x16x32_bf16(xl, bh[s4][nt], acc[x][nt], 0, 0, 0);
                                acc[x][nt] = __builtin_amdgcn_mfma_f32_16x16x32_bf16(xh, bl[s4][nt], acc[x][nt], 0, 0, 0);
                                acc[x][nt] = __builtin_amdgcn_mfma_f32_16x16x32_bf16(xh, bh[s4][nt], acc[x][nt], 0, 0, 0); } }
                }
#pragma unroll
                for (int x = 0; x < 2; ++x) {
#pragma unroll
                    for (int nt = 0; nt < 3; ++nt)
#pragma unroll
                        for (int e = 0; e < 4; ++e) part[(wave * 32 + 16 * x + 4 * kg + e) * 48 + 16 * nt + li] = acc[x][nt][e];
                    float s1 = ss[x]; s1 += __shfl_xor(s1, 16); s1 += __shfl_xor(s1, 32);
                    if (kg == 0) ssp[wave * 32 + 16 * x + li] = s1; }
            }
            __syncthreads();
            for (int idx = tid; idx < 32 * 48; idx += 512) { float a = 0.f;
#pragma unroll
                for (int w8 = 0; w8 < 8; ++w8) a += part[w8 * 1536 + idx];
                logit[idx] = a; }
            if (tid < 32) { float a = 0.f;
#pragma unroll
                for (int w8 = 0; w8 < 8; ++w8) a += ssp[w8 * 32 + tid];
                const float r = __builtin_amdgcn_rsqf(a * (1.f / DM) + NORM_EPS); rsl[tid] = r; rstd_g[t0 + tid] = r; }
            __syncthreads();
            if (tid < 32) {
                const float rstd = rsl[tid]; const LAS float* lg = logit + tid * 48;
                int gidx = 0; float gmax = lg[0] * rstd + args.b_rg[0]; float glv[4]; glv[0] = gmax;
#pragma unroll
                for (int k = 1; k < 4; ++k) { glv[k] = lg[k] * rstd + args.b_rg[k]; if (glv[k] > gmax) { gmax = glv[k]; gidx = k; } }
                float gden = 0.f;
#pragma unroll
                for (int k = 0; k < 4; ++k) gden += __expf(glv[k] - gmax);
                const float gwt = 1.f / gden;
                int i0 = 0, i1 = -1; float v0 = -3.0e38f, v1 = -3.0e38f;
                for (int k = 0; k < 8; ++k) { const float v = lg[4 + 8 * gidx + k] * rstd + args.b_re[gidx * EPG + k];
                    if (v > v0) { v1 = v0; i1 = i0; v0 = v; i0 = k; } else if (v > v1) { v1 = v; i1 = k; } }
                const float p0 = 1.f / (1.f + __expf(v1 - v0)), p1 = 1.f - p0;
                selE[2 * tid] = gidx * EPG + i0; selE[2 * tid + 1] = gidx * EPG + i1; selW[2 * tid] = gwt * p0; selW[2 * tid + 1] = gwt * p1;
            }
            __syncthreads();
            if (wave == 0 && lane < NEXP) {
                const int e = lane; int cnt = 0;
                for (int i = 0; i < 64; ++i) cnt += (selE[i] == e) ? 1 : 0;
                unsigned base = 0u;
                if (cnt) base = __hip_atomic_fetch_add((unsigned*)(ctl + CW_CNT + 64 * e), (unsigned)cnt, RLX_AGENT);
                for (int i = 0; i < 64; ++i) if (selE[i] == e) { const int t = t0 + (i >> 1); ltok[e * SEQ + base] = t; lw[e * SEQ + base] = selW[i]; tokpos[2 * t + (i & 1)] = (e << 16) | (int)base; ++base; }
            }
            __syncthreads();
        }
        if (BOTH(4)) GRID_BAR();
    }

    if (IN(5) || IN(6) || IN(7)) {
        LAS int* mtok = (LAS int*)(lds + MOE_TOK_OFF); LAS float* mw = (LAS float*)(lds + MOE_W_OFF); LAS float* mr = (LAS float*)(lds + MOE_R_OFF); LAS int* tb = (LAS int*)(lds + MOE_TB_OFF);
        pg8::MoeOrder S{tb, G, bx};
        { const int tid = TID();
        if (tid == 0) { int acc = 0; for (int e = 0; e < NEXP; ++e) { const int c = (int)__hip_atomic_load((unsigned*)(ctl + CW_CNT + 64 * e), RLX_AGENT); tb[e] = acc; tb[33 + e] = c; acc += (c + 255) >> 8; } tb[32] = acc; }
        __syncthreads();
        for (int i = 0; i < MAXU; ++i) { pg8::Unit u; if (!S.next(i, u)) break;
            if (tid < 256) { const int idx = 256 * u.lt + tid; const bool valid = idx < tb[33 + u.e];
                const int tk = valid ? ltok[u.e * SEQ + idx] : -1;
                mtok[i * 256 + tid] = tk; mw[i * 256 + tid] = valid ? lw[u.e * SEQ + idx] : 0.f; mr[i * 256 + tid] = valid ? ((const float*)(ws + WS_RSTD))[tk] : 0.f; } }
        }
        __syncthreads();
        if (IN(5)) {
            pg8::Gemm g{XN, BTGU, DM / 2};
            pg8::EpiSwiGLU E{Hb, mw, mr};
            pg8::gemm_phase<pg8::EpiSwiGLU, pg8::MoeOrder, true, true, true>(lds, g, S, E, mtok, TID());
            {
                const int units = tb[32] * 8, rem = units % G, tailb = rem > 0 ? G - rem : G, ti = rem > 0 ? bx - rem : bx;
                if (ti >= 0) { const int lane = lane_id_v(); const int q = (CV_N5 + tailb * 8 - 1) / (tailb * 8), x0 = (ti * 8 + wave) * q, x1 = (x0 + q < CV_N5) ? x0 + q : CV_N5;
                    convert_range(args.w_gate, args.w_up, args.w_down, BTGU, BTD, CV_GU + CV_D - CV_N5 + x0, CV_GU + CV_D - CV_N5 + x1, lds + wave * 8448, lane); }
            }
            if (BOTH(5)) GRID_BAR();
        }
        if (IN(6)) {
            pg8::Gemm g{Hb, BTD, DFF};
            pg8::EpiYStore E{Yb};
            pg8::gemm_phase<pg8::EpiYStore, pg8::MoeOrder, true, false, false>(lds, g, S, E, nullptr, TID());
            if (BOTH(6)) GRID_BAR();
        }
        if (IN(7)) {
            const int lane = lane_id_v();
            const int* tokpos = (const int*)(ws + WS_TOKPOS);
            for (int t = gw; t < SEQ; t += NGW) {
                const int c0 = tokpos[2 * t], c1 = tokpos[2 * t + 1];
                const size_t r0 = (size_t)(256 * tb[c0 >> 16] + (c0 & 0xffff)), r1 = (size_t)(256 * tb[c1 >> 16] + (c1 & 0xffff));
                const GAS f32x4* xo = (const GAS f32x4*)(args.out + (size_t)t * DM) + lane; GAS f32x4* xw = (GAS f32x4*)(args.out_w + (size_t)t * DM) + lane;
                const GAS v2u* y0 = (const GAS v2u*)(Yb + r0 * DM) + lane; const GAS v2u* y1 = (const GAS v2u*)(Yb + r1 * DM) + lane;
#pragma unroll
                for (int j = 0; j < 8; ++j) { f32x4 a = __builtin_nontemporal_load(xo + 64 * j); const v2u b0 = __builtin_nontemporal_load(y0 + 64 * j), b1 = __builtin_nontemporal_load(y1 + 64 * j);
                    a.x = (a.x + bf_lo(b0.x)) + bf_lo(b1.x); a.y = (a.y + bf_hi(b0.x)) + bf_hi(b1.x); a.z = (a.z + bf_lo(b0.y)) + bf_lo(b1.y); a.w = (a.w + bf_hi(b0.y)) + bf_hi(b1.y);
                    __builtin_nontemporal_store(a, xw + 64 * j); }
            }
        }
    }
#undef IN
#undef BOTH
#undef GRID_BAR
#undef TID
}

extern "C" void kernel_launch(void* const* d_in, const int* in_sizes, int n_in, void* d_out, int out_size, void* d_ws, size_t ws_size, hipStream_t stream) {
    static int grid = 0;
    if (grid == 0) {
        if (n_in != 19 || out_size != SEQ * DM || ws_size < WS_END) { fprintf(stderr, "kernel_launch: unexpected sizes (n_in %d out %d ws %zu)\n", n_in, out_size, ws_size); grid = -1; return; }
        int dev = 0, cus = 0, per_cu = 0;
        if (hipGetDevice(&dev) != hipSuccess || hipDeviceGetAttribute(&cus, hipDeviceAttributeMultiprocessorCount, dev) != hipSuccess) { grid = -1; return; }
        if (hipFuncSetAttribute((const void*)hymba_fwd, hipFuncAttributeMaxDynamicSharedMemorySize, LDS_BYTES) != hipSuccess) { fprintf(stderr, "kernel_launch: hipFuncSetAttribute failed\n"); grid = -1; return; }
        if (hipOccupancyMaxActiveBlocksPerMultiprocessor(&per_cu, (const void*)hymba_fwd, 512, LDS_BYTES) != hipSuccess || per_cu < 1) fprintf(stderr, "kernel_launch: occupancy query reports %d\n", per_cu);
        (void)hipGetLastError();
        grid = cus;
    }
    if (grid < 0) return;
    if (hipMemsetAsync((char*)d_ws + WS_CTL, 0, CTL_ZERO_BYTES, stream) != hipSuccess) return;
    Args a{};
    a.x = (const float*)d_in[0]; a.norm1_g = (const float*)d_in[1]; a.w_in = (const float*)d_in[2]; a.q_norm_g = (const float*)d_in[3]; a.k_norm_g = (const float*)d_in[4];
    a.conv_w = (const float*)d_in[5]; a.conv_b = (const float*)d_in[6]; a.conv_ln_g = (const float*)d_in[7]; a.conv_ln_b = (const float*)d_in[8]; a.rel_bias = (const float*)d_in[9];
    a.w_out = (const float*)d_in[10]; a.norm2_g = (const float*)d_in[11]; a.w_rg = (const float*)d_in[12]; a.b_rg = (const float*)d_in[13]; a.w_re = (const float*)d_in[14]; a.b_re = (const float*)d_in[15];
    a.w_gate = (const float*)d_in[16]; a.w_up = (const float*)d_in[17]; a.w_down = (const float*)d_in[18];
    a.out = (float*)d_out; a.out_w = (float*)d_out; a.ws = (unsigned char*)d_ws;
    if (N_LAUNCHES == 1) { a.ph_lo = 0; a.ph_hi = N_PHASES; hipLaunchKernelGGL(hymba_fwd, dim3(grid), dim3(512), LDS_BYTES, stream, a); }
    else {
#ifndef MK_PROBE
#define MK_PROBE -1
#endif
        for (int p = 0; p < N_PHASES; ++p) { a.ph_lo = p; a.ph_hi = p + 1; hipLaunchKernelGGL(hymba_fwd, dim3(grid), dim3(512), LDS_BYTES, stream, a);
            if (p == MK_PROBE) { Args b = a;
                if (p == 7) b.out_w = (float*)((char*)d_ws + WS_Q);
                if (p == 4) { b.ws = (unsigned char*)d_ws + 700 * MiB; (void)hipMemsetAsync(b.ws, 0, CTL_ZERO_BYTES, stream); }
                hipLaunchKernelGGL(hymba_fwd, dim3(grid), dim3(512), LDS_BYTES, stream, b); } }
    }
}
```

```cpp
#include <hip/hip_runtime.h>
#include <cstdio>
#include <cstdint>

#ifndef MK_N_LAUNCHES
#define MK_N_LAUNCHES 1
#endif
constexpr int N_LAUNCHES = MK_N_LAUNCHES;
constexpr int N_PHASES = 8;

#define GAS __attribute__((address_space(1)))
#define LAS __attribute__((address_space(3)))
typedef unsigned short bf16;
typedef unsigned v4u __attribute__((ext_vector_type(4)));
typedef unsigned v2u __attribute__((ext_vector_type(2)));
typedef float f32x4 __attribute__((ext_vector_type(4)));
typedef float f32x2 __attribute__((ext_vector_type(2)));
typedef short bf16x8 __attribute__((ext_vector_type(8)));
typedef short s16x4 __attribute__((ext_vector_type(4)));
typedef GAS unsigned gu32;
typedef int v8i __attribute__((ext_vector_type(8)));
typedef int v4i __attribute__((ext_vector_type(4)));
#define RLX_AGENT __ATOMIC_RELAXED, __HIP_MEMORY_SCOPE_AGENT
#define LDS_WAIT() asm volatile("s_waitcnt lgkmcnt(0)" ::: "memory")
#define VM_WAIT() asm volatile("s_waitcnt vmcnt(0)" ::: "memory")

constexpr int SEQ = 8192, DM = 2048, CCH = 1024, AW = 1024, NH = 16, HD = 64, INW = 5120, CONVW = 31;
constexpr int NGRP = 4, EPG = 8, NEXP = 32, DFF = 1024;
constexpr float NORM_EPS = 1e-6f;
constexpr float LOG2E = 1.4426950408889634f;
constexpr float C2 = 0.125f * LOG2E;
constexpr int MAXT = 96;
constexpr int MAXU = 3;

constexpr size_t MiB = 1u << 20;
constexpr size_t WS_CTL = 0, CTL_ZERO_BYTES = 40960;
constexpr size_t WS_LTOK = 1 * MiB;
constexpr size_t WS_LW = 2 * MiB;
constexpr size_t WS_BTIN = 4 * MiB;
constexpr size_t WS_BTOUT = 24 * MiB;
constexpr size_t WS_XN = 32 * MiB;
constexpr size_t WS_U = 64 * MiB;
constexpr size_t WS_Q = 80 * MiB, WS_K = 96 * MiB, WS_V = 112 * MiB;
constexpr size_t WS_MIX = 128 * MiB;
constexpr size_t WS_H = 160 * MiB;
constexpr size_t WS_BTGU = 208 * MiB;
constexpr size_t WS_BTD = 464 * MiB;
constexpr size_t WS_Y = 592 * MiB;
constexpr size_t WS_END = 688 * MiB;
constexpr size_t WS_TOKPOS = 3 * MiB;
constexpr size_t WS_RSTD = 3 * MiB + 65536;
constexpr size_t WS_WRH = 3 * MiB + 131072;
constexpr size_t WS_WRL = WS_WRH + 48 * 2048 * 2;
constexpr int CW_BAR = 0;
constexpr int CW_CNT = 4096;
static_assert((CW_CNT + 64 * 32) * 4 <= (int)CTL_ZERO_BYTES && 3456 <= CW_CNT, "control words inside the zeroed region");

constexpr int RING_BYTES = 131072;
constexpr int MOE_TOK_OFF = RING_BYTES;
constexpr int MOE_W_OFF = MOE_TOK_OFF + MAXU * 1024;
constexpr int MOE_R_OFF = MOE_W_OFF + MAXU * 1024;
constexpr int MOE_TB_OFF = MOE_R_OFF + MAXU * 1024;
constexpr int MISC_OFF = MOE_TB_OFF + 512;
constexpr int LDS_BYTES = 147456;
static_assert(MISC_OFF + 64 <= LDS_BYTES, "LDS map");

__device__ __forceinline__ unsigned f2bf(float f) { unsigned u = __builtin_bit_cast(unsigned, f); return (u + 0x7fffu + ((u >> 16) & 1u)) >> 16; }
__device__ __forceinline__ unsigned pk2(float lo, float hi) { return f2bf(lo) | (f2bf(hi) << 16); }
__device__ __forceinline__ unsigned cvt_pk_bf16(float lo, float hi) { unsigned r; asm volatile("v_cvt_pk_bf16_f32 %0, %1, %2" : "=v"(r) : "v"(lo), "v"(hi)); return r; }
typedef __bf16 bf16x2_t __attribute__((ext_vector_type(2)));
__device__ __forceinline__ unsigned cvt_pk_s(float lo, float hi) { const f32x2 v = {lo, hi}; const bf16x2_t b = __builtin_convertvector(v, bf16x2_t); return __builtin_bit_cast(unsigned, b); }
__device__ __forceinline__ unsigned pk4_fp8(float a, float b, float c, float d) { int p = 0; p = __builtin_amdgcn_cvt_pk_fp8_f32(a, b, p, false); p = __builtin_amdgcn_cvt_pk_fp8_f32(c, d, p, true); return (unsigned)p; }
constexpr float W8_SCALE = 64.f, H8_SCALE = 16.f;
__device__ __forceinline__ float bf_lo(unsigned u) { return __builtin_bit_cast(float, u << 16); }
__device__ __forceinline__ float bf_hi(unsigned u) { return __builtin_bit_cast(float, u & 0xffff0000u); }
__device__ __forceinline__ float sigmoidf_(float x) { return __builtin_amdgcn_rcpf(1.f + __expf(-x)); }
__device__ __forceinline__ int lane_id_v() { int l; asm volatile("v_mbcnt_lo_u32_b32 %0, -1, 0\n\tv_mbcnt_hi_u32_b32 %0, -1, %0" : "=v"(l)); return l; }
__device__ __forceinline__ float wave_sum(float v) {
#pragma unroll
    for (int o = 1; o < 64; o <<= 1) v += __shfl_xor(v, o);
    return v;
}

__constant__ unsigned char kBucket[3][132] = {
 {0,1,2,3,4,5,6,7,8,9,10,11,12,13,14,15,16,16,16,16,16,16,17,17,17,17,17,17,17,17,18,18,18,18,18,18,18,18,18,18,19,19,19,19,19,19,19,19,19,19,19,19,19,19,20,20,20,20,20,20,20,20,20,20,20,20,20,20,20,20,20,20,20,21,21,21,21,21,21,21,21,21,21,21,21,21,21,21,21,21,21,21,21,21,21,21,21,21,21,22,22,22,22,22,22,22,22,22,22,22,22,22,22,22,22,22,22,22,22,22,22,22,22,22,22,22,22,22,22,0,0,0},
 {0,4,8,12,16,16,17,17,18,18,19,19,19,19,20,20,20,20,20,21,21,21,21,21,21,22,22,22,22,22,22,22,22,22,23,23,23,23,23,23,23,23,23,23,23,23,24,24,24,24,24,24,24,24,24,24,24,24,24,24,24,24,25,25,25,25,25,25,25,25,25,25,25,25,25,25,25,25,25,25,25,25,25,26,26,26,26,26,26,26,26,26,26,26,26,26,26,26,26,26,26,26,26,26,26,26,26,26,26,26,26,26,26,27,27,27,27,27,27,27,27,27,27,27,27,27,27,27,27,0,0,0},
 {0,16,18,19,20,21,21,22,22,23,23,23,24,24,24,24,25,25,25,25,25,26,26,26,26,26,26,26,26,27,27,27,27,27,27,27,27,27,27,28,28,28,28,28,28,28,28,28,28,28,28,28,29,29,29,29,29,29,29,29,29,29,29,29,29,29,29,29,29,29,30,30,30,30,30,30,30,30,30,30,30,30,30,30,30,30,30,30,30,30,30,30,30,30,30,31,31,31,31,31,31,31,31,31,31,31,31,31,31,31,31,31,31,31,31,31,31,31,31,31,31,31,31,31,31,31,31,31,31,0,0,0}};

namespace pg8 {
constexpr int BM = 256, BK = 64, HALF = 128, HTB = HALF * BK * 2, STAGE_BYTES = 8 * HTB, NXCD = 8, WGM = 8;
__host__ __device__ __forceinline__ int lds_byte(int r, int c) { const int st = (r >> 4) * 2 + (c >> 5), rr = r & 15, cc = c & 31, ob = rr * 64 + cc * 2; return st * 1024 + (ob ^ (((ob >> 9) & 1) << 5)); }
__host__ __device__ __forceinline__ void stage_rc(int b, int& R, int& C) { const int st = b / 1024, sb = b % 1024, swz = sb ^ (((sb >> 9) & 1) << 5); R = (st >> 1) * 16 + swz / 64; C = (st & 1) * 32 + (swz % 64) / 2; }
__host__ __device__ __forceinline__ int perm32(int rho) { const int n = rho >> 4, i = rho & 15; return 8 * (i >> 2) + 4 * n + (i & 3); }

struct Unit { int pm, pn, e, lt, slot; };
struct Gemm { const bf16* A; const bf16* Bt; int K; };

struct StaticOrder {
    int nM, nN, nwg, G, c;
    __host__ __device__ void init(int M, int N, int G_, int c_) { nM = M / BM; nN = N / BM; nwg = nM * nN; G = G_; c = c_; }
    __host__ __device__ bool next(int i, Unit& u) const {
        const long L = (long)i * G + c; if (L >= nwg) return false;
        int wgid = (int)L; { const int q = nwg / NXCD, r = nwg % NXCD, xcd = wgid % NXCD, off = wgid / NXCD; wgid = (xcd < r ? xcd * (q + 1) : r * (q + 1) + (xcd - r) * q) + off; }
        const int nig = WGM * nN, gid = wgid / nig, fm = gid * WGM, gsz = (nM - fm) < WGM ? (nM - fm) : WGM;
        u.pm = fm + ((wgid % nig) % gsz); u.pn = (wgid % nig) / gsz; u.e = 0; u.lt = 0; u.slot = i; return true;
    }
};
struct MoeOrder {
    const LAS int* tb; int G, c;
    __device__ __forceinline__ bool next(int i, Unit& u) const {
        const int L = i * G + c, NT = __builtin_amdgcn_readfirstlane(tb[32]);
        if (i >= MAXU || L >= NT * 8) return false;
        const int T = L >> 3, n = L & 7; int e = 0;
#pragma unroll
        for (int k = 1; k < 32; ++k) e += (tb[k] <= T) ? 1 : 0;
        e = __builtin_amdgcn_readfirstlane(e);
        u.pm = T; u.pn = e * 8 + n; u.e = e; u.lt = __builtin_amdgcn_readfirstlane(T - tb[e]); u.slot = i; return true;
    }
};

template <class Epi, class Sched, bool ALIGN_EPI, bool GATHER, bool F8 = false>
__device__ __forceinline__ void gemm_phase(LAS unsigned char* lds, const Gemm g, const Sched& S, const Epi& E, const LAS int* gtok, const int tid) {
    const int wid = __builtin_amdgcn_readfirstlane(tid >> 6), lane = tid & 63, wr = wid >> 2, wc = wid & 3, fr = lane & 15, fq = lane >> 4;
    const int K = g.K, nt = K / BK;
    const size_t kstep = (size_t)(BK * 2);
    const size_t hstep = (size_t)HALF * K * 2;
    const size_t tstep = 2 * hstep;
    unsigned voffB[2], vA[2][2];
#pragma unroll
    for (int i = 0; i < 2; ++i) { int R, C; stage_rc(tid * 16 + i * 8192, R, C); const int Rb = Epi::PERM ? ((R & ~31) + perm32(R & 31)) : R;
        voffB[i] = (unsigned)(Rb * K + C) * 2u;
        vA[0][i] = (unsigned)(R * K + C) * 2u; vA[1][i] = vA[0][i] + (unsigned)hstep; }
    const unsigned ldsw = (unsigned)wid * 1024u;
    const int aoff = lds_byte(wr * 64 + fr, fq * 8), boff = lds_byte(wc * 32 + fr, fq * 8);
#define PG8_SA(b, h) (((b) * 2 + (h)) * HTB)
#define PG8_SB(b, h) ((4 + (b) * 2 + (h)) * HTB)
#define PG8_STAGE(bufoff, gbase, voff) do { const char* _gb = (const char*)(gbase); asm volatile("" : "+s"(_gb)); _Pragma("unroll") for (int _i = 0; _i < 2; ++_i) { unsigned _vo = (voff)[_i]; asm volatile("" : "+v"(_vo)); \
        __builtin_amdgcn_global_load_lds((const unsigned*)(_gb + _vo), (LAS unsigned*)(lds + (bufoff) + ldsw + _i * 8192), 16, 0, 0); } } while (0)
#define PG8_GLOAD(v, slot_) do { const int _t = wid * 64 + lane_id_v(); _Pragma("unroll") for (int _i = 0; _i < 2; ++_i) { int _R, _C; stage_rc(_t * 16 + _i * 8192, _R, _C); \
        _Pragma("unroll") for (int _h = 0; _h < 2; ++_h) { int _tk = gtok[(slot_) * 256 + 128 * _h + _R]; _tk = _tk < 0 ? 0 : _tk; v[_h][_i] = (unsigned)(_tk * K + _C) * 2u; } } } while (0)
#define PG8_LDA(dst, b, h) do { if constexpr (F8) { _Pragma("unroll") for (int m = 0; m < 4; ++m) { const v4i _lo = *(const LAS v4i*)(lds + PG8_SA(b, h) + aoff + m * 2048), _hi = *(const LAS v4i*)(lds + PG8_SA(b, h) + aoff + m * 2048 + 1024); \
            dst##8[m] = __builtin_shufflevector(_lo, _hi, 0, 1, 2, 3, 4, 5, 6, 7); } } \
        else { _Pragma("unroll") for (int m = 0; m < 4; ++m) _Pragma("unroll") for (int k = 0; k < 2; ++k) dst[m][k] = *(const LAS bf16x8*)(lds + PG8_SA(b, h) + aoff + m * 2048 + k * 1024); } } while (0)
#define PG8_LDB(dst, b, h) do { if constexpr (F8) { _Pragma("unroll") for (int n = 0; n < 2; ++n) { const v4i _lo = *(const LAS v4i*)(lds + PG8_SB(b, h) + boff + n * 2048), _hi = *(const LAS v4i*)(lds + PG8_SB(b, h) + boff + n * 2048 + 1024); \
            dst##8[n] = __builtin_shufflevector(_lo, _hi, 0, 1, 2, 3, 4, 5, 6, 7); } } \
        else { _Pragma("unroll") for (int n = 0; n < 2; ++n) _Pragma("unroll") for (int k = 0; k < 2; ++k) dst[n][k] = *(const LAS bf16x8*)(lds + PG8_SB(b, h) + boff + n * 2048 + k * 1024); } } while (0)
#define PG8_MMA(ai, bj, At, Bt) do { __builtin_amdgcn_s_setprio(1); \
        if constexpr (F8) { _Pragma("unroll") for (int m = 0; m < 4; ++m) _Pragma("unroll") for (int n = 0; n < 2; ++n) \
            acc[ai][bj][m][n] = __builtin_amdgcn_mfma_scale_f32_16x16x128_f8f6f4(Bt##8[n], At##8[m], acc[ai][bj][m][n], 0, 0, 0, 0x7f7f7f7f, 0, 0x7f7f7f7f); } \
        else { _Pragma("unroll") for (int m = 0; m < 4; ++m) _Pragma("unroll") for (int n = 0; n < 2; ++n) _Pragma("unroll") for (int k = 0; k < 2; ++k) \
            acc[ai][bj][m][n] = __builtin_amdgcn_mfma_f32_16x16x32_bf16(Bt[n][k], At[m][k], acc[ai][bj][m][n], 0, 0, 0); } \
        __builtin_amdgcn_s_setprio(0); } while (0)
#define PG8_WAIT_V(n) asm volatile("s_waitcnt vmcnt(" #n ")" ::: "memory")
#define PG8_WAIT_L(n) asm volatile("s_waitcnt lgkmcnt(" #n ")" ::: "memory")
#define PG8_BAR __builtin_amdgcn_s_barrier()
#define PG8_SCHED __builtin_amdgcn_sched_barrier(0)
    Unit cur, nxt; int ui = 0;
    if (!S.next(0, cur)) return;
    f32x4 acc[2][2][4][2];
#pragma unroll
    for (int a = 0; a < 2; ++a)
#pragma unroll
        for (int b = 0; b < 2; ++b)
#pragma unroll
            for (int m = 0; m < 4; ++m)
#pragma unroll
                for (int n = 0; n < 2; ++n) acc[a][b][m][n] = (f32x4){0.f, 0.f, 0.f, 0.f};
    bf16x8 At[4][2], B0[2][2], B1[2][2]; v8i At8[4], B08[2], B18[2];
    const char* cA = GATHER ? (const char*)g.A : (const char*)g.A + (size_t)cur.pm * tstep; const char* cB = (const char*)g.Bt + (size_t)cur.pn * tstep;
    if constexpr (GATHER) { PG8_GLOAD(vA, cur.slot); }
    PG8_STAGE(PG8_SB(0, 0), cB, voffB); PG8_STAGE(PG8_SB(0, 1), cB + hstep, voffB); PG8_STAGE(PG8_SA(0, 0), cA, vA[0]); PG8_STAGE(PG8_SA(0, 1), cA, vA[1]);
    if (wr == 1) PG8_BAR;
    PG8_WAIT_V(2); PG8_BAR;
    PG8_STAGE(PG8_SB(1, 0), cB + kstep, voffB); PG8_STAGE(PG8_SA(1, 0), cA + kstep, vA[0]); PG8_STAGE(PG8_SB(1, 1), cB + hstep + kstep, voffB);
    PG8_WAIT_V(6); PG8_BAR;
    for (;;) {
        const bool has_next = S.next(ui + 1, nxt);
        const char* nA = GATHER ? cA : (has_next ? (const char*)g.A + (size_t)nxt.pm * tstep : cA); const char* nB = has_next ? (const char*)g.Bt + (size_t)nxt.pn * tstep : cB;

#pragma unroll 1
        for (int t = 0; t < nt; t += 2) {
            const bool last = (t == nt - 2);
            const char* a1 = cA + (size_t)(t + 1) * kstep;
            const char* a2 = last ? nA : cA + (size_t)(t + 2) * kstep; const char* b2 = last ? nB : cB + (size_t)(t + 2) * kstep;
            const char* a3 = a2 + kstep; const char* b3 = b2 + kstep;
            unsigned vS[2][2];
#pragma unroll
            for (int h = 0; h < 2; ++h)
#pragma unroll
                for (int i = 0; i < 2; ++i) vS[h][i] = vA[h][i];
            if constexpr (GATHER) { if (last && has_next) { PG8_GLOAD(vS, nxt.slot); } }

            PG8_LDB(B0, 0, 0); PG8_LDB(B1, 0, 1); PG8_SCHED; PG8_LDA(At, 0, 0); PG8_STAGE(PG8_SA(1, 1), a1, vA[1]);
            PG8_WAIT_V(8); PG8_WAIT_L(0); PG8_BAR; PG8_MMA(0, 0, At, B0); PG8_MMA(0, 1, At, B1); PG8_BAR; PG8_SCHED;
            PG8_LDA(At, 0, 1); PG8_STAGE(PG8_SB(0, 0), b2, voffB); PG8_STAGE(PG8_SB(0, 1), b2 + hstep, voffB); PG8_STAGE(PG8_SA(0, 0), a2, vS[0]);
            PG8_WAIT_V(8); PG8_WAIT_L(0); PG8_BAR; PG8_MMA(1, 0, At, B0); PG8_MMA(1, 1, At, B1); PG8_BAR; PG8_SCHED;
            PG8_LDB(B0, 1, 0); PG8_LDB(B1, 1, 1); PG8_SCHED; PG8_LDA(At, 1, 0); PG8_STAGE(PG8_SA(0, 1), a2, vS[1]);
            PG8_WAIT_V(8); PG8_WAIT_L(0); PG8_BAR; PG8_MMA(0, 0, At, B0); PG8_MMA(0, 1, At, B1); PG8_BAR; PG8_SCHED;
            PG8_LDA(At, 1, 1); PG8_STAGE(PG8_SB(1, 0), b3, voffB); PG8_STAGE(PG8_SB(1, 1), b3 + hstep, voffB); PG8_STAGE(PG8_SA(1, 0), a3, vS[0]);
            PG8_WAIT_V(8); PG8_WAIT_L(0); PG8_BAR; PG8_MMA(1, 0, At, B0); PG8_MMA(1, 1, At, B1); PG8_BAR; PG8_SCHED;
        }
        if constexpr (ALIGN_EPI) { if (wr == 0) PG8_BAR; }
        { const int _l = lane_id_v();
          E(acc, cur, wr, wc, _l & 15, _l >> 4); }
        if (!has_next) break;
#pragma unroll
        for (int a = 0; a < 2; ++a)
#pragma unroll
            for (int b = 0; b < 2; ++b)
#pragma unroll
                for (int m = 0; m < 4; ++m)
#pragma unroll
                    for (int n = 0; n < 2; ++n) acc[a][b][m][n] = (f32x4){0.f, 0.f, 0.f, 0.f};
        cur = nxt; cA = nA; cB = nB; ++ui;
        if constexpr (GATHER) { PG8_GLOAD(vA, cur.slot); }
        if constexpr (ALIGN_EPI) { if (wr == 1) PG8_BAR; }
    }
    PG8_WAIT_V(0);
    if constexpr (!ALIGN_EPI) { if (wr == 0) PG8_BAR; }
    PG8_BAR;
#undef PG8_SA
#undef PG8_SB
#undef PG8_STAGE
#undef PG8_GLOAD
#undef PG8_LDA
#undef PG8_LDB
#undef PG8_MMA
#undef PG8_WAIT_V
#undef PG8_WAIT_L
#undef PG8_BAR
#undef PG8_SCHED
}

typedef const f32x4 (&AccRef)[2][2][4][2];
struct EpiInProj {
    static constexpr bool PERM = true;
    bf16 *U, *Q, *Kb, *V; const float *qg, *kg;
    __device__ __forceinline__ void operator()(AccRef acc, const Unit& u, int wr, int wc, int fr, int fq) const {
        const int row0 = u.pm * BM + wr * 64 + fr;
        if (u.pn < 8) {
#pragma unroll
            for (int ai = 0; ai < 2; ++ai)
#pragma unroll
                for (int m = 0; m < 4; ++m) { const int r = row0 + ai * HALF + m * 16;
                    f32x4 a0 = acc[ai][0][m][0], a1 = acc[ai][0][m][1], g0 = acc[ai][1][m][0], g1 = acc[ai][1][m][1];
                    v4u w; w.x = cvt_pk_bf16(a0[0] * sigmoidf_(g0[0]), a0[1] * sigmoidf_(g0[1])); w.y = cvt_pk_bf16(a0[2] * sigmoidf_(g0[2]), a0[3] * sigmoidf_(g0[3]));
                    w.z = cvt_pk_bf16(a1[0] * sigmoidf_(g1[0]), a1[1] * sigmoidf_(g1[1])); w.w = cvt_pk_bf16(a1[2] * sigmoidf_(g1[2]), a1[3] * sigmoidf_(g1[3]));
                    *(v4u*)(U + (size_t)r * CCH + 128 * u.pn + 32 * wc + 8 * fq) = w; }
        } else if (u.pn < 16) {
            const int t = u.pn - 8, tensor = t >> 2, head = 4 * (t & 3) + wc;
            const float* gn = tensor ? kg : qg; bf16* dst = tensor ? Kb : Q; const float sc0 = tensor ? 1.f : C2;
            f32x4 gv[2][2];
#pragma unroll
            for (int bj = 0; bj < 2; ++bj)
#pragma unroll
                for (int n = 0; n < 2; ++n) gv[bj][n] = *(const f32x4*)(gn + 32 * bj + 8 * fq + 4 * n);
#pragma unroll
            for (int ai = 0; ai < 2; ++ai)
#pragma unroll
                for (int m = 0; m < 4; ++m) { const int r = row0 + ai * HALF + m * 16; float ss = 0.f;
#pragma unroll
                    for (int bj = 0; bj < 2; ++bj)
#pragma unroll
                        for (int n = 0; n < 2; ++n) { const f32x4 v = acc[ai][bj][m][n]; ss += (v[0] * v[0] + v[1] * v[1]) + (v[2] * v[2] + v[3] * v[3]); }
                    ss += __shfl_xor(ss, 16); ss += __shfl_xor(ss, 32);
                    const float sc = sc0 * __builtin_amdgcn_rsqf(ss * (1.f / 64.f) + NORM_EPS);
#pragma unroll
                    for (int bj = 0; bj < 2; ++bj) { const f32x4 v0 = acc[ai][bj][m][0] * gv[bj][0] * sc, v1 = acc[ai][bj][m][1] * gv[bj][1] * sc;
                        v4u w; w.x = cvt_pk_bf16(v0[0], v0[1]); w.y = cvt_pk_bf16(v0[2], v0[3]); w.z = cvt_pk_bf16(v1[0], v1[1]); w.w = cvt_pk_bf16(v1[2], v1[3]);
                        *(v4u*)(dst + (size_t)r * AW + 64 * head + 32 * bj + 8 * fq) = w; } }
        } else {
            const int cb = 256 * (u.pn - 16) + 32 * wc + 8 * fq;
#pragma unroll
            for (int ai = 0; ai < 2; ++ai)
#pragma unroll
                for (int m = 0; m < 4; ++m) { const int r = row0 + ai * HALF + m * 16;
#pragma unroll
                    for (int bj = 0; bj < 2; ++bj) { const f32x4 v0 = acc[ai][bj][m][0], v1 = acc[ai][bj][m][1];
                        v4u w; w.x = cvt_pk_bf16(v0[0], v0[1]); w.y = cvt_pk_bf16(v0[2], v0[3]); w.z = cvt_pk_bf16(v1[0], v1[1]); w.w = cvt_pk_bf16(v1[2], v1[3]);
                        *(v4u*)(V + (size_t)r * AW + cb + 128 * bj) = w; } }
        }
    }
};
struct EpiResF32 {
    static constexpr bool PERM = true;
    const float* X; float* O; bf16* HN; const float* g2;
    __device__ __forceinline__ void operator()(AccRef acc, const Unit& u, int wr, int wc, int fr, int fq) const {
        const int row0 = u.pm * BM + wr * 64 + fr, col0 = u.pn * BM + wc * 32 + 8 * fq;
        f32x4 gv[2][2];
#pragma unroll
        for (int bj = 0; bj < 2; ++bj)
#pragma unroll
            for (int n = 0; n < 2; ++n) gv[bj][n] = *(const f32x4*)(g2 + col0 + bj * HALF + 4 * n);
#pragma unroll
        for (int ai = 0; ai < 2; ++ai)
#pragma unroll
            for (int m = 0; m < 4; ++m) { const size_t ro = (size_t)(row0 + ai * HALF + m * 16) * DM + col0;
                f32x4 xv[2][2];
#pragma unroll
                for (int bj = 0; bj < 2; ++bj)
#pragma unroll
                    for (int n = 0; n < 2; ++n) xv[bj][n] = __builtin_nontemporal_load((const f32x4*)(X + ro + bj * HALF + 4 * n));
#pragma unroll
                for (int bj = 0; bj < 2; ++bj) { const f32x4 a = xv[bj][0] + acc[ai][bj][m][0], b = xv[bj][1] + acc[ai][bj][m][1];
                    *(f32x4*)(O + ro + bj * HALF) = a; *(f32x4*)(O + ro + bj * HALF + 4) = b;
                    const f32x4 ha = a * gv[bj][0], hb = b * gv[bj][1];
                    v2u w; w.x = pk4_fp8(ha[0], ha[1], ha[2], ha[3]); w.y = pk4_fp8(hb[0], hb[1], hb[2], hb[3]);
                    *(v2u*)((unsigned char*)HN + ro + bj * HALF) = w; } }
    }
};
struct EpiSwiGLU {
    static constexpr bool PERM = true;
    bf16* H; const LAS float* wts; const LAS float* rs;
    __device__ __forceinline__ void operator()(AccRef acc, const Unit& u, int wr, int wc, int fr, int fq) const {
        const int cb = 128 * (u.pn & 7) + 32 * wc + 8 * fq;
#pragma unroll
        for (int ai = 0; ai < 2; ++ai)
#pragma unroll
            for (int m = 0; m < 4; ++m) { const int R = ai * HALF + wr * 64 + m * 16 + fr; const float r = rs[u.slot * 256 + R] * (1.f / W8_SCALE), w = wts[u.slot * 256 + R] * r * H8_SCALE;
                const f32x4 g0 = acc[ai][0][m][0] * r, g1 = acc[ai][0][m][1] * r, u0 = acc[ai][1][m][0] * w, u1 = acc[ai][1][m][1] * w;
                v2u o; o.x = pk4_fp8(g0[0] * sigmoidf_(g0[0]) * u0[0], g0[1] * sigmoidf_(g0[1]) * u0[1], g0[2] * sigmoidf_(g0[2]) * u0[2], g0[3] * sigmoidf_(g0[3]) * u0[3]);
                o.y = pk4_fp8(g1[0] * sigmoidf_(g1[0]) * u1[0], g1[1] * sigmoidf_(g1[1]) * u1[1], g1[2] * sigmoidf_(g1[2]) * u1[2], g1[3] * sigmoidf_(g1[3]) * u1[3]);
                *(v2u*)((unsigned char*)H + (size_t)(u.pm * BM + R) * DFF + cb) = o; }
    }
};
struct EpiYStore {
    static constexpr bool PERM = true;
    bf16* Y;
    __device__ __forceinline__ void operator()(AccRef acc, const Unit& u, int wr, int wc, int fr, int fq) const {
        const int cb = 256 * (u.pn & 7) + 32 * wc + 8 * fq;
#pragma unroll
        for (int ai = 0; ai < 2; ++ai)
#pragma unroll
            for (int m = 0; m < 4; ++m) { const int R = ai * HALF + wr * 64 + m * 16 + fr;
#pragma unroll
                for (int bj = 0; bj < 2; ++bj) { const f32x4 v0 = acc[ai][bj][m][0] * (1.f / (W8_SCALE * H8_SCALE)), v1 = acc[ai][bj][m][1] * (1.f / (W8_SCALE * H8_SCALE));
                    v4u w; w.x = cvt_pk_bf16(v0[0], v0[1]); w.y = cvt_pk_bf16(v0[2], v0[3]); w.z = cvt_pk_bf16(v1[0], v1[1]); w.w = cvt_pk_bf16(v1[2], v1[3]);
                    *(v4u*)(Y + (size_t)(u.pm * BM + R) * DM + cb + 128 * bj) = w; } }
    }
};
struct EpiScatter {
    static constexpr bool PERM = false;
    float* O; const LAS int* toks;
    __device__ __forceinline__ void operator()(AccRef acc, const Unit& u, int wr, int wc, int fr, int fq) const {
        const int col0 = (u.pn & 7) * BM + wc * 32 + 4 * fq;
#pragma unroll
        for (int ai = 0; ai < 2; ++ai)
#pragma unroll
            for (int m = 0; m < 4; ++m) { const int R = ai * HALF + wr * 64 + m * 16 + fr; const int tok = toks[u.slot * 256 + R];
                if (tok >= 0) { float* ro = O + (size_t)tok * DM + col0;
#pragma unroll
                    for (int bj = 0; bj < 2; ++bj)
#pragma unroll
                        for (int n = 0; n < 2; ++n) { const f32x4 v = acc[ai][bj][m][n]; float* p = ro + bj * HALF + n * 16;
                            unsafeAtomicAdd(p + 0, v[0]); unsafeAtomicAdd(p + 1, v[1]); unsafeAtomicAdd(p + 2, v[2]); unsafeAtomicAdd(p + 3, v[3]); } } }
    }
};
}

#define XB_TMO      128
#define XB_XCNT(j)  (256  + 64 * (j))
#define XB_XSUB(j)  (1280 + 64 * (j))
#define XB_XGEN(j)  (2304 + 64 * (j))
#define XB_TOP      3328
#define XB_TOPGEN   3392
#define XCD_BAR_WORDS 3456
#define XB_SPIN_CAP (1u << 18)
__device__ __forceinline__ unsigned xb_ld(unsigned* p)              { return __hip_atomic_load(p, __ATOMIC_RELAXED, __HIP_MEMORY_SCOPE_AGENT); }
__device__ __forceinline__ unsigned xb_add(unsigned* p, unsigned v) { return __hip_atomic_fetch_add(p, v, __ATOMIC_RELAXED, __HIP_MEMORY_SCOPE_AGENT); }
__device__ __forceinline__ unsigned xb_xcc_id() { return (unsigned)__builtin_amdgcn_s_getreg((3 << 11) | 20) & 0xFu; }
#define XB_SPIN(cond, bar) do { unsigned _sp = 0; while (cond) { __builtin_amdgcn_s_sleep(1); \
    if ((++_sp & 255u) == 0u) { if (xb_ld(&(bar)[XB_TMO])) break; if (_sp > XB_SPIN_CAP) { atomicAdd(&(bar)[XB_TMO], 1u); break; } } } } while (0)
struct XcdBarrier { unsigned* bar; unsigned x; volatile LAS unsigned* st; };
__device__ __forceinline__ XcdBarrier xcd_barrier_post(unsigned* bar, volatile LAS unsigned* st, const int tid) {
    XcdBarrier b; b.bar = bar; b.x = xb_xcc_id(); b.st = st;
    if (tid == 0) (void)xb_add(&bar[XB_XCNT(b.x)], 1u);
    return b;
}
__device__ __forceinline__ void xcd_barrier_complete(unsigned* bar, unsigned x, unsigned& nloc, unsigned& nx) {
    const unsigned G = gridDim.x * gridDim.y * gridDim.z;
    unsigned sum, cnt, mine, sp = 0u;
    for (;;) {
        sum = 0u; cnt = 0u; mine = 0u;
#pragma unroll
        for (unsigned j = 0; j < 16; ++j) { const unsigned c = xb_ld(&bar[XB_XCNT(j)]); sum += c; cnt += (c > 0u) ? 1u : 0u; mine = (j == x) ? c : mine; }
        if (sum == G) break;
        __builtin_amdgcn_s_sleep(1);
        if ((++sp & 255u) == 0u) { if (xb_ld(&bar[XB_TMO])) break; if (sp > XB_SPIN_CAP) { atomicAdd(&bar[XB_TMO], 1u); break; } }
    }
    nloc = mine > 0u ? mine : 1u; nx = cnt > 0u ? cnt : 1u;
}
__device__ __forceinline__ void xcd_barrier(const XcdBarrier& b, const int tid) {
    asm volatile("s_waitcnt vmcnt(0)" ::: "memory");
    __syncthreads();
    if (tid == 0) {
        unsigned* bar = b.bar;
        __builtin_amdgcn_s_waitcnt(0);
        unsigned nloc = b.st[0], nx = b.st[1];
        if (nloc == 0u) { xcd_barrier_complete(bar, b.x, nloc, nx); b.st[0] = nloc; b.st[1] = nx; }
        const unsigned old = xb_add(&bar[XB_XSUB(b.x)], 1u);
        const unsigned gen = old / nloc;
        if (old + 1u == (gen + 1u) * nloc) {
            __builtin_amdgcn_fence(__ATOMIC_RELEASE, "agent");
            asm volatile("s_waitcnt vmcnt(0)" ::: "memory");
            const unsigned og = xb_add(&bar[XB_TOP], 1u);
            const unsigned tg = og / nx;
            if (og + 1u == (tg + 1u) * nx) xb_add(&bar[XB_TOPGEN], 1u);
            else XB_SPIN(xb_ld(&bar[XB_TOPGEN]) == tg, bar);
            __builtin_amdgcn_fence(__ATOMIC_ACQUIRE, "agent");
            xb_add(&bar[XB_XGEN(b.x)], 1u);
            asm volatile("s_waitcnt vmcnt(0)" ::: "memory");
        } else {
            XB_SPIN(xb_ld(&bar[XB_XGEN(b.x)]) == gen, bar);
            __builtin_amdgcn_fence(__ATOMIC_ACQUIRE, "agent");
            asm volatile("s_waitcnt vmcnt(0)" ::: "memory");
        }
    }
    __syncthreads();
}

struct Args {
    const float *x, *norm1_g, *w_in, *q_norm_g, *k_norm_g, *conv_w, *conv_b, *conv_ln_g, *conv_ln_b, *rel_bias, *w_out, *norm2_g, *w_rg, *b_rg, *w_re, *b_re, *w_gate, *w_up, *w_down;
    float* out; float* out_w; unsigned char* ws; int ph_lo, ph_hi;
};

__device__ __forceinline__ void transpose_item(const float* Wsrc, int ldw, bf16* dst, int ldd, LAS float* scr, int lane) {
    const float* p = Wsrc + (size_t)(lane >> 5) * ldw + (lane & 31);
#pragma unroll 1
    for (int hh = 0; hh < 2; ++hh) {
        float tv[16];
#pragma unroll
        for (int i = 0; i < 16; ++i) { tv[i] = *p; p += 2 * ldw; }
#pragma unroll
        for (int i = 0; i < 16; ++i) { const int kk = 2 * (16 * hh + i) + (lane >> 5); scr[kk * 33 + (lane & 31)] = tv[i]; }
    }
    LDS_WAIT(); asm volatile("" ::: "memory");
    const int c = lane & 7;
#pragma unroll
    for (int j = 0; j < 4; ++j) { const int n = (lane >> 3) + 8 * j; const LAS float* s = scr + (8 * c) * 33 + n;
        v4u o; o.x = pk2(s[0 * 33], s[1 * 33]); o.y = pk2(s[2 * 33], s[3 * 33]); o.z = pk2(s[4 * 33], s[5 * 33]); o.w = pk2(s[6 * 33], s[7 * 33]);
        *(GAS v4u*)(dst + (size_t)n * ldd + 8 * c) = o; }
    LDS_WAIT(); asm volatile("" ::: "memory");
}
__device__ __forceinline__ void t64_load(const float* Wsrc, int ldw, int lane, f32x4 (&tv)[16]) {
    const float* p = Wsrc + (size_t)(lane >> 3) * ldw + 4 * (lane & 7);
#pragma unroll
    for (int i = 0; i < 16; ++i) { tv[i] = __builtin_nontemporal_load((const f32x4*)p); p += 8 * ldw; }
}
__device__ __forceinline__ void t64_finish(const f32x4 (&tv)[16], unsigned char* dst, int ldd, int f8, LAS unsigned char* scr, int lane) {
    const int g = lane >> 4, i16 = lane & 15;
#pragma unroll
    for (int i = 0; i < 16; ++i) { v2u w; w.x = cvt_pk_bf16(tv[i].x, tv[i].y); w.y = cvt_pk_bf16(tv[i].z, tv[i].w); *(LAS v2u*)(scr + (8 * i + (lane >> 3)) * 64 + 8 * (lane & 7)) = w; }
    LDS_WAIT(); asm volatile("" ::: "memory");
    const int q = i16 >> 2, pp = i16 & 3;
    bf16x8 o[8];
#pragma unroll
    for (int jj = 0; jj < 8; ++jj) { const int c = 4 * jj + g, nb = c & 1, kg = c >> 1;
        LAS unsigned char* ra = scr + (8 * kg + q) * 64 + 32 * nb + 8 * pp;
        const s16x4 lo = __builtin_bit_cast(s16x4, __builtin_amdgcn_ds_read_tr16_b64_v4i16((LAS s16x4*)ra));
        const s16x4 hi = __builtin_bit_cast(s16x4, __builtin_amdgcn_ds_read_tr16_b64_v4i16((LAS s16x4*)(ra + 4 * 64)));
        o[jj] = __builtin_shufflevector(lo, hi, 0, 1, 2, 3, 4, 5, 6, 7); }
    LDS_WAIT(); asm volatile("" ::: "memory");
#pragma unroll
    for (int jj = 0; jj < 8; ++jj) { const int c = 4 * jj + g, nb = c & 1, kg = c >> 1; const int n = 16 * nb + i16;
        *(LAS bf16x8*)(scr + n * 256 + 16 * (kg ^ (n & 15))) = o[jj]; }
    LDS_WAIT(); asm volatile("" ::: "memory");
    const int rr = lane >> 3, cc = lane & 7;
#pragma unroll
    for (int it = 0; it < 4; ++it) { const int n = 8 * it + rr;
        const v4u v0 = *(const LAS v4u*)(scr + n * 256 + 16 * ((2 * cc) ^ (n & 15))), v1 = *(const LAS v4u*)(scr + n * 256 + 16 * ((2 * cc + 1) ^ (n & 15)));
        if (f8) { v4u o4; o4.x = pk4_fp8(bf_lo(v0.x) * W8_SCALE, bf_hi(v0.x) * W8_SCALE, bf_lo(v0.y) * W8_SCALE, bf_hi(v0.y) * W8_SCALE);
            o4.y = pk4_fp8(bf_lo(v0.z) * W8_SCALE, bf_hi(v0.z) * W8_SCALE, bf_lo(v0.w) * W8_SCALE, bf_hi(v0.w) * W8_SCALE);
            o4.z = pk4_fp8(bf_lo(v1.x) * W8_SCALE, bf_hi(v1.x) * W8_SCALE, bf_lo(v1.y) * W8_SCALE, bf_hi(v1.y) * W8_SCALE);
            o4.w = pk4_fp8(bf_lo(v1.z) * W8_SCALE, bf_hi(v1.z) * W8_SCALE, bf_lo(v1.w) * W8_SCALE, bf_hi(v1.w) * W8_SCALE);
            __builtin_nontemporal_store(o4, (GAS v4u*)(dst + (size_t)n * ldd + 16 * cc)); }
        else { *(GAS v4u*)(dst + (size_t)n * ldd + 32 * cc) = v0; *(GAS v4u*)(dst + (size_t)n * ldd + 32 * cc + 16) = v1; } }
    LDS_WAIT(); asm volatile("" ::: "memory");
}
__device__ __forceinline__ int win_src_col(int n0) {
    const int pn = n0 >> 8, j = n0 & 255;
    if (pn < 8) return ((j >> 7) ? CCH : 0) + 128 * pn + (j & 127);
    if (pn < 16) { const int t = pn - 8, tensor = t >> 2, head = 4 * (t & 3) + ((j >> 5) & 3), dim = 32 * (j >> 7); return 2 * CCH + AW * tensor + 64 * head + dim; }
    return 2 * CCH + 2 * AW + 256 * (pn - 16) + j;
}
__device__ __forceinline__ void rms_row_to_bf16(const float* xrow, const float* g, bf16* orow, int lane) {
    const GAS f32x4* xr = (const GAS f32x4*)xrow + lane; const GAS f32x4* gr = (const GAS f32x4*)g + lane;
    f32x4 v[8]; float s = 0.f;
#pragma unroll
    for (int j = 0; j < 8; ++j) { v[j] = xr[64 * j]; s += (v[j].x * v[j].x + v[j].y * v[j].y) + (v[j].z * v[j].z + v[j].w * v[j].w); }
    const float rstd = __builtin_amdgcn_rsqf(wave_sum(s) * (1.f / DM) + NORM_EPS);
    GAS v2u* o8 = (GAS v2u*)orow + lane;
#pragma unroll
    for (int j = 0; j < 8; ++j) { const f32x4 gg = gr[64 * j]; v2u w; w.x = pk2(v[j].x * rstd * gg.x, v[j].y * rstd * gg.y); w.y = pk2(v[j].z * rstd * gg.z, v[j].w * rstd * gg.w); o8[64 * j] = w; }
}

template <int P, int NT>
__device__ __forceinline__ void attn_pattern(const bf16* __restrict__ Kh, const bf16* __restrict__ Vh, const int t0, LAS unsigned char* vbuf, const LAS float* bt,
                                             const bf16x8 (&qf)[NT][2], f32x4 (&o)[NT][4], f32x4 (&lacc)[NT], int lane) {
    constexpr int DL = (P == 0) ? 1 : (P == 1) ? 4 : 16, SQ = 16 / DL, GS = 3, NGRPS = (P == 0) ? 4 : 2;
    constexpr int SH = 8 / DL;
    static_assert(NT == 1 || P < 2, "tile pairs share keys only for dilation 1 and 4");
    const int qi = lane & 15, g = lane >> 4, q4 = qi >> 2, pp = qi & 3;
    const int xr = (2 * g + (q4 >> 1)) & 3;
    unsigned tra[4];
#pragma unroll
    for (int dt = 0; dt < 4; ++dt) tra[dt] = (unsigned)((4 * g + q4) * 128 + 32 * (dt ^ xr) + 8 * pp);
    unsigned klo[2], vlo[4], vwa[4];
#pragma unroll
    for (int tt = 0; tt < 2; ++tt) klo[tt] = (unsigned)(DL * (16 * tt + qi) * AW + 8 * g);
#pragma unroll
    for (int k = 0; k < 4; ++k) { const int idx = lane + 64 * k, row = idx >> 3, c16 = idx & 7; vlo[k] = (unsigned)(DL * row * AW + 8 * c16); vwa[k] = (unsigned)(row * 128 + 16 * (c16 ^ (((row >> 1) & 3) << 1))); }
    const int tq = t0 / DL;
    unsigned relmax[NT];
#pragma unroll
    for (int x = 0; x < NT; ++x) { const int m = SQ * qi + tq + x * SH; relmax[x] = (unsigned)(m < 128 ? m : 128); }
    const int relb = 128 + SQ * qi - 4 * g;
    const bf16x8 ones = (bf16x8){0x3f80, 0x3f80, 0x3f80, 0x3f80, 0x3f80, 0x3f80, 0x3f80, 0x3f80};
#pragma unroll 1
    for (int grp = 0; grp < NGRPS; ++grp) {
        bf16x8 kfg[GS][2][2]; v4u vrg[GS][4];
#pragma unroll
        for (int s3 = 0; s3 < GS; ++s3) { if (P == 2 && GS * grp + s3 >= 5) break;
            const long ro = ((long)t0 + DL * (32 * (GS * grp + s3) - 128)) * AW; const bf16* kb = Kh + ro; const bf16* vbs = Vh + ro;
#pragma unroll
            for (int tt = 0; tt < 2; ++tt) { kfg[s3][tt][0] = *(const bf16x8*)(kb + klo[tt]); kfg[s3][tt][1] = *(const bf16x8*)(kb + klo[tt] + 32); }
#pragma unroll
            for (int k = 0; k < 4; ++k) vrg[s3][k] = *(const v4u*)(vbs + vlo[k]); }
#pragma unroll
        for (int s3 = 0; s3 < GS; ++s3) {
            const int c = GS * grp + s3;
            if (P == 2 && c >= 5) break;
            LAS unsigned char* vb = vbuf + s3 * 4096;
#pragma unroll
            for (int k = 0; k < 4; ++k) *(LAS v4u*)(vb + vwa[k]) = vrg[s3][k];
            const int rel0 = relb - 32 * c;
            bf16x8 pf[NT];
#pragma unroll
            for (int x = 0; x < NT; ++x) {
                f32x4 sc[2];
#pragma unroll
                for (int tt = 0; tt < 2; ++tt) { f32x4 z = (f32x4){0.f, 0.f, 0.f, 0.f};
                    z = __builtin_amdgcn_mfma_f32_16x16x32_bf16(kfg[s3][tt][0], qf[x][0], z, 0, 0, 0);
                    sc[tt] = __builtin_amdgcn_mfma_f32_16x16x32_bf16(kfg[s3][tt][1], qf[x][1], z, 0, 0, 0); }
                const LAS float* btp = bt + (rel0 + x * SH - 19);
                float p[2][4];
#pragma unroll
                for (int tt = 0; tt < 2; ++tt)
#pragma unroll
                    for (int e = 0; e < 4; ++e) { const int rel = rel0 + x * SH - 16 * tt - e;
                        const float pe = __builtin_amdgcn_exp2f(sc[tt][e] + btp[19 - 16 * tt - e]);
                        p[tt][e] = ((unsigned)rel <= relmax[x]) ? pe : 0.f; }
                v4u pw; pw.x = cvt_pk_s(p[0][0], p[0][1]); pw.y = cvt_pk_s(p[0][2], p[0][3]); pw.z = cvt_pk_s(p[1][0], p[1][1]); pw.w = cvt_pk_s(p[1][2], p[1][3]);
                pf[x] = __builtin_bit_cast(bf16x8, pw);
                lacc[x] = __builtin_amdgcn_mfma_f32_16x16x32_bf16(ones, pf[x], lacc[x], 0, 0, 0);
            }
#pragma unroll
            for (int dt = 0; dt < 4; ++dt) {
                const s16x4 lo = __builtin_bit_cast(s16x4, __builtin_amdgcn_ds_read_tr16_b64_v4i16((LAS s16x4*)(vb + tra[dt])));
                const s16x4 hi = __builtin_bit_cast(s16x4, __builtin_amdgcn_ds_read_tr16_b64_v4i16((LAS s16x4*)(vb + tra[dt] + 2048)));
                const bf16x8 vf = __builtin_shufflevector(lo, hi, 0, 1, 2, 3, 4, 5, 6, 7);
#pragma unroll
                for (int x = 0; x < NT; ++x) o[x][dt] = __builtin_amdgcn_mfma_f32_16x16x32_bf16(vf, pf[x], o[x][dt], 0, 0, 0);
            }
        }
    }
}

__device__ __forceinline__ void attn_wave(const bf16* Q, const bf16* Kb, const bf16* Vb, bf16* MIX, int h, const int t0, LAS unsigned char* vbuf, const LAS float* bt, int lane) {
    asm volatile("" : "+v"(lane));
    const int qi = lane & 15, g = lane >> 4;
    bf16x8 qf[2][2]; f32x4 o[2][4]; f32x4 lacc[2];
#pragma unroll
    for (int x = 0; x < 2; ++x) { const bf16* qrow = Q + (size_t)(t0 + 8 * x + 16 * qi) * AW + 64 * h + 8 * g; qf[x][0] = *(const bf16x8*)qrow; qf[x][1] = *(const bf16x8*)(qrow + 32);
        lacc[x] = (f32x4){0.f, 0.f, 0.f, 0.f};
#pragma unroll
        for (int dt = 0; dt < 4; ++dt) o[x][dt] = (f32x4){0.f, 0.f, 0.f, 0.f}; }
    const bf16* Kh = Kb + 64 * h; const bf16* Vh = Vb + 64 * h;
    attn_pattern<0, 2>(Kh, Vh, t0, vbuf, bt, qf, o, lacc, lane);
    attn_pattern<1, 2>(Kh, Vh, t0, vbuf, bt + 132, qf, o, lacc, lane);
#pragma unroll
    for (int x = 0; x < 2; ++x) {
        bf16x8 q1[1][2] = {{qf[x][0], qf[x][1]}}; f32x4 o1[1][4] = {{o[x][0], o[x][1], o[x][2], o[x][3]}}; f32x4 l1[1] = {lacc[x]};
        attn_pattern<2, 1>(Kh, Vh, t0 + 8 * x, vbuf, bt + 264, q1, o1, l1, lane);
        const float inv = 1.f / l1[0][0];
        bf16* orow = MIX + (size_t)(t0 + 8 * x + 16 * qi) * DM + CCH + 64 * h + 4 * g;
#pragma unroll
        for (int dt = 0; dt < 4; ++dt) { v2u w; w.x = cvt_pk_bf16(o1[0][dt][0] * inv, o1[0][dt][1] * inv); w.y = cvt_pk_bf16(o1[0][dt][2] * inv, o1[0][dt][3] * inv); *(v2u*)(orow + 16 * dt) = w; }
    }
}

constexpr int CV_IN = (DM / 64) * (INW / 32), CV_OUT = (DM / 64) * (DM / 32), CV_GU = NEXP * 2 * (DM / 128) * (DFF / 32), CV_D = NEXP * (DFF / 128) * (DM / 32);
constexpr int CV_SMALL = CV_IN + CV_OUT, CV_ALL = CV_SMALL + CV_GU + CV_D;
constexpr int P1_ROUNDS = 4;
constexpr int CV_N1 = 28672, CV_N5 = 4096;
__device__ __forceinline__ void convert_item(const float* w_in, const float* w_out, int r, bf16* BTIN, bf16* BTOUT, LAS float* scr, int lane) {
    if (r < CV_IN) { const int nblk = INW / 32, kb = r / nblk, nb = r % nblk; transpose_item(w_in + (size_t)(64 * kb) * INW + win_src_col(32 * nb), INW, BTIN + (size_t)(32 * nb) * DM + 64 * kb, DM, scr, lane); return; }
    r -= CV_IN;
    { const int nblk = DM / 32, kb = r / nblk, nb = r % nblk; transpose_item(w_out + (size_t)(64 * kb) * DM + 32 * nb, DM, BTOUT + (size_t)(32 * nb) * DM + 64 * kb, DM, scr, lane); }
}
struct XItem { const float* src; unsigned char* dst; int ldw, ldd, f8; };
__device__ __forceinline__ XItem xitem(const float* w_gate, const float* w_up, const float* w_down, bf16* BTGU, bf16* BTD, int r) {
    XItem it;
    if (r < CV_GU) { const int per = (DM / 128) * (DFF / 32); const int e = r / (2 * per), r2 = r % (2 * per), which = r2 / per, r3 = r2 % per; const int nblk = DFF / 32, kb = r3 / nblk, nb = r3 % nblk;
        const float* W = (which ? w_up : w_gate) + (size_t)e * DM * DFF;
        const int f0 = 32 * nb, brow = 256 * (f0 >> 7) + 128 * which + (f0 & 127);
        it.src = W + (size_t)(128 * kb) * DFF + f0; it.ldw = DFF; it.dst = (unsigned char*)BTGU + ((size_t)e * 2048 + brow) * DM + 128 * kb; it.ldd = DM; it.f8 = 1; return it; }
    r -= CV_GU;
    { const int per = (DFF / 128) * (DM / 32); const int e = r / per, r3 = r % per; const int nblk = DM / 32, kb = r3 / nblk, nb = r3 % nblk;
        it.src = w_down + (size_t)e * DFF * DM + (size_t)(128 * kb) * DM + 32 * nb; it.ldw = DM; it.dst = (unsigned char*)BTD + ((size_t)e * DM + 32 * nb) * DFF + 128 * kb; it.ldd = DFF; it.f8 = 1; return it; }
}
__device__ __forceinline__ void convert_range(const float* w_gate, const float* w_up, const float* w_down, bf16* BTGU, bf16* BTD, int x0, int x1, LAS unsigned char* scr, int lane) {
    if (x0 >= x1) return;
    f32x4 ta[16], tc[16];
    XItem A = xitem(w_gate, w_up, w_down, BTGU, BTD, x0), B = A;
    t64_load(A.src, A.ldw, lane, ta);
#pragma unroll 1
    for (int x = x0; x < x1; x += 2) {
        const bool hasB = x + 1 < x1;
        if (hasB) { B = xitem(w_gate, w_up, w_down, BTGU, BTD, x + 1); t64_load(B.src, B.ldw, lane, tc); }
        t64_finish(ta, A.dst, A.ldd, A.f8, scr, lane);
        if (hasB) {
            if (x + 2 < x1) { A = xitem(w_gate, w_up, w_down, BTGU, BTD, x + 2); t64_load(A.src, A.ldw, lane, ta); }
            t64_finish(tc, B.dst, B.ldd, B.f8, scr, lane);
        }
    }
}

__global__ void __launch_bounds__(512, 2) hymba_fwd(Args args) {
    extern __shared__ __attribute__((aligned(16))) unsigned char lds_raw[];
    LAS unsigned char* lds = (LAS unsigned char*)lds_raw;
    const int wave = __builtin_amdgcn_readfirstlane(threadIdx.x >> 6);
#define TID() (wave * 64 + lane_id_v())
    const int G = gridDim.x, bx = blockIdx.x;
    unsigned char* ws = args.ws;
    gu32* ctl = (gu32*)(ws + WS_CTL);
    int* ltok = (int*)(ws + WS_LTOK); float* lw = (float*)(ws + WS_LW);
    bf16* BTIN = (bf16*)(ws + WS_BTIN); bf16* BTOUT = (bf16*)(ws + WS_BTOUT); bf16* XN = (bf16*)(ws + WS_XN); bf16* Ub = (bf16*)(ws + WS_U);
    bf16* Qb = (bf16*)(ws + WS_Q); bf16* Kb = (bf16*)(ws + WS_K); bf16* Vb = (bf16*)(ws + WS_V); bf16* MIX = (bf16*)(ws + WS_MIX); bf16* Hb = (bf16*)(ws + WS_H);
    bf16* BTGU = (bf16*)(ws + WS_BTGU); bf16* BTD = (bf16*)(ws + WS_BTD); bf16* Yb = (bf16*)(ws + WS_Y);
    volatile LAS unsigned* MISC = (volatile LAS unsigned*)(lds + MISC_OFF);
    { const int tid = TID(); if (tid < 16) MISC[tid] = 0u; }
    __syncthreads();
    XcdBarrier bar; bar.bar = (unsigned*)(ctl + CW_BAR); bar.x = 0; bar.st = nullptr;
    if (N_LAUNCHES == 1) bar = xcd_barrier_post((unsigned*)(ctl + CW_BAR), MISC, TID());
    const int lo = args.ph_lo, hi = args.ph_hi;
#define IN(k) (lo <= (k) && (k) < hi)
#define BOTH(k) (IN(k) && IN((k) + 1))
#define GRID_BAR() xcd_barrier(bar, TID())
    const int gw = bx * 8 + wave, NGW = G * 8;

    if (IN(0)) {
        const int lane = lane_id_v();
        LAS float* scr = (LAS float*)(lds + wave * 16384);
        for (int it = gw; it < CV_SMALL; it += NGW) convert_item(args.w_in, args.w_out, it, BTIN, BTOUT, scr, lane);
        for (int m = gw; m < SEQ; m += NGW) rms_row_to_bf16(args.x + (size_t)m * DM, args.norm1_g, XN + (size_t)m * DM, lane);
        {
            bf16* WRH = (bf16*)(ws + WS_WRH); bf16* WRL = (bf16*)(ws + WS_WRL);
            for (int idx = gw * 64 + lane; idx < 48 * DM; idx += NGW * 64) { const int j = idx / DM, d = idx % DM;
                float w = 0.f;
                if (j < 4) w = args.w_rg[d * NGRP + j]; else if (j < 36) w = args.w_re[((size_t)((j - 4) >> 3) * DM + d) * EPG + ((j - 4) & 7)];
                w *= args.norm2_g[d];
                const unsigned hi = f2bf(w); const float rem = w - __builtin_bit_cast(float, hi << 16);
                WRH[idx] = (bf16)hi; WRL[idx] = (bf16)f2bf(rem); }
        }
        if (BOTH(0)) GRID_BAR();
    }

    if (IN(1)) {
        const int units = (SEQ / 256) * (INW / 256), GG = (G >= 256) ? (units + P1_ROUNDS - 1) / P1_ROUNDS : G, FB = G - GG;
        if (bx < GG) {
            pg8::Gemm g{XN, BTIN, DM}; pg8::StaticOrder S; S.init(SEQ, INW, GG, bx);
            pg8::EpiInProj E{Ub, Qb, Kb, Vb, args.q_norm_g, args.k_norm_g};
            pg8::gemm_phase<pg8::EpiInProj, pg8::StaticOrder, true, false>(lds, g, S, E, nullptr, TID());
        }
        {   const int lane = lane_id_v();
            const int nb = FB > 0 ? FB : G, ti = FB > 0 ? bx - GG : bx;
            if (ti >= 0) { const int q = (CV_N1 + nb * 8 - 1) / (nb * 8), x0 = (ti * 8 + wave) * q, x1 = (x0 + q < CV_N1) ? x0 + q : CV_N1;
                convert_range(args.w_gate, args.w_up, args.w_down, BTGU, BTD, x0, x1, lds + wave * 8448, lane); }
        }
        if (BOTH(1)) GRID_BAR();
    }

    if (IN(2)) {
        LAS float* btab = (LAS float*)(lds + 8 * 12288);
        const int tid = TID(), lane = tid & 63;
        {
            float mq = 0.f, mk = 0.f;
            for (int d = 0; d < HD; ++d) { mq = fmaxf(mq, fabsf(args.q_norm_g[d])); mk = fmaxf(mk, fabsf(args.k_norm_g[d])); }
            for (int idx = tid; idx < NH * 3 * 132; idx += 512) { const int h = idx / 396, r2 = idx % 396, p = r2 / 132, rel = r2 % 132;
                float mb = 0.f; for (int b = 0; b < 32; ++b) mb = fmaxf(mb, fabsf(args.rel_bias[b * NH + h]));
                const float Mh = 1.02f * C2 * 64.f * mq * mk + mb * LOG2E;
                btab[idx] = args.rel_bias[(int)kBucket[p][rel] * NH + h] * LOG2E - Mh; }
        }
        __syncthreads();
        LAS unsigned char* vbuf = lds + wave * 12288;
        {
            constexpr int CV_LO = CV_N1, CV_HI = CV_GU + CV_D - CV_N5, CV_EXP = CV_HI - CV_LO;
            const int nA = (512 - bx + G - 1) / G;
            const int per_wave = (CV_EXP + NGW - 1) / NGW;
            const int c_lo = CV_LO + gw * per_wave, c_hi = (c_lo + per_wave < CV_HI) ? c_lo + per_wave : CV_HI;
            const int nsteps = nA > 0 ? nA : 1, per_batch = (per_wave + nsteps - 1) / nsteps;
            int ia = 0, ic = c_lo;
#pragma unroll 1
            for (int hs = 0; hs < 2 * nsteps; ++hs) {
                const bool doA = (((hs & 1) == 0) == (wave < 4));
                if (doA) { if (ia < nA) { const int a = bx + ia * G; const int blk = a >> 4, h = a & 15;
                        attn_wave(Qb, Kb, Vb, MIX, h, 256 * blk + wave, vbuf, btab + h * 396, lane); ++ia; } }
                else { const int ce = (ic + per_batch < c_hi) ? ic + per_batch : c_hi;
                    convert_range(args.w_gate, args.w_up, args.w_down, BTGU, BTD, ic, ce, vbuf, lane); ic = ce > ic ? ce : ic; }
            }
            convert_range(args.w_gate, args.w_up, args.w_down, BTGU, BTD, ic, c_hi, vbuf, lane);
        }
        __syncthreads();
        LAS float* cv = (LAS float*)lds;
        for (int ct = bx; ct < SEQ / 32; ct += G) {
            const int tb0 = 32 * ct, c0 = 2 * tid;
            float w0[CONVW], w1[CONVW];
#pragma unroll
            for (int j = 0; j < CONVW; ++j) { const f32x2 w = *(const f32x2*)(args.conv_w + j * CCH + c0); w0[j] = w.x; w1[j] = w.y; }
            const f32x2 cb = *(const f32x2*)(args.conv_b + c0);
            unsigned uw[62];
#pragma unroll
            for (int i = 0; i < 62; ++i) { const int tr = tb0 - 30 + i; uw[i] = (tr >= 0) ? *(const unsigned*)(Ub + (size_t)tr * CCH + c0) : 0u; }
#pragma unroll
            for (int i = 0; i < 32; ++i) { float a0 = cb.x, a1 = cb.y;
#pragma unroll
                for (int j = 0; j < CONVW; ++j) { a0 += w0[j] * bf_lo(uw[i + j]); a1 += w1[j] * bf_hi(uw[i + j]); }
                *(LAS f32x2*)(cv + i * CCH + c0) = (f32x2){a0, a1}; }
            __syncthreads();
#pragma unroll 1
            for (int i = wave; i < 32; i += 8) {
                f32x4 v[4]; float s = 0.f;
#pragma unroll
                for (int k = 0; k < 4; ++k) { v[k] = *(const LAS f32x4*)(cv + i * CCH + 4 * lane + 256 * k); s += (v[k].x + v[k].y) + (v[k].z + v[k].w); }
                const float mean = wave_sum(s) * (1.f / CCH); float s2 = 0.f;
#pragma unroll
                for (int k = 0; k < 4; ++k) { v[k] = v[k] - mean; s2 += (v[k].x * v[k].x + v[k].y * v[k].y) + (v[k].z * v[k].z + v[k].w * v[k].w); }
                const float rstd = __builtin_amdgcn_rsqf(wave_sum(s2) * (1.f / CCH) + NORM_EPS);
                bf16* orow = MIX + (size_t)(tb0 + i) * DM;
#pragma unroll
                for (int k = 0; k < 4; ++k) { const int c = 4 * lane + 256 * k; const f32x4 gg = *(const f32x4*)(args.conv_ln_g + c), bb = *(const f32x4*)(args.conv_ln_b + c);
                    f32x4 y = v[k] * rstd * gg + bb; y.x *= sigmoidf_(y.x); y.y *= sigmoidf_(y.y); y.z *= sigmoidf_(y.z); y.w *= sigmoidf_(y.w);
                    v2u w; w.x = pk2(y.x, y.y); w.y = pk2(y.z, y.w); *(v2u*)(orow + c) = w; }
            }
            __syncthreads();
        }
        if (BOTH(2)) GRID_BAR();
    }

    if (IN(3)) {
        pg8::Gemm g{MIX, BTOUT, DM}; pg8::StaticOrder S; S.init(SEQ, DM, G, bx);
        pg8::EpiResF32 E{args.x, args.out, XN, args.norm2_g};
        pg8::gemm_phase<pg8::EpiResF32, pg8::StaticOrder, true, false>(lds, g, S, E, nullptr, TID());
        if (BOTH(3)) GRID_BAR();
    }

    if (IN(4)) {
        const int tid = TID(), lane = tid & 63, li = lane & 15, kg = lane >> 4;
        LAS float* part = (LAS float*)lds;
        LAS float* logit = (LAS float*)(lds + 49152);
        LAS float* ssp = (LAS float*)(lds + 49152 + 6144);
        LAS float* rsl = ssp + 256;
        LAS int* selE = (LAS int*)(rsl + 32); LAS float* selW = (LAS float*)(selE + 64);
        int* tokpos = (int*)(ws + WS_TOKPOS); float* rstd_g = (float*)(ws + WS_RSTD);
        const bf16* WRH = (const bf16*)(ws + WS_WRH); const bf16* WRL = (const bf16*)(ws + WS_WRL);
        constexpr int NTILE = SEQ / 32;
        for (int tile = bx; tile < NTILE; tile += G) {
            const int t0 = 32 * tile;
            {
                const float* xp = args.out + (size_t)(t0 + li) * DM + 256 * wave + 8 * kg;
                const bf16* hp = WRH + (size_t)li * DM + 256 * wave + 8 * kg; const bf16* lp = WRL + (size_t)li * DM + 256 * wave + 8 * kg;
                f32x4 acc[2][3]; float ss[2] = {0.f, 0.f};
#pragma unroll
                for (int x = 0; x < 2; ++x)
#pragma unroll
                    for (int nt = 0; nt < 3; ++nt) acc[x][nt] = (f32x4){0.f, 0.f, 0.f, 0.f};
#pragma unroll 1
                for (int hf = 0; hf < 2; ++hf) {
                    f32x4 xa[2][4][2]; bf16x8 bh[4][3], bl[4][3];
#pragma unroll
                    for (int s4 = 0; s4 < 4; ++s4) { const int ko = 32 * (4 * hf + s4);
#pragma unroll
                        for (int x = 0; x < 2; ++x) { xa[x][s4][0] = *(const f32x4*)(xp + (size_t)(16 * x) * DM + ko); xa[x][s4][1] = *(const f32x4*)(xp + (size_t)(16 * x) * DM + ko + 4); }
#pragma unroll
                        for (int nt = 0; nt < 3; ++nt) { bh[s4][nt] = *(const bf16x8*)(hp + (size_t)(16 * nt) * DM + ko); bl[s4][nt] = *(const bf16x8*)(lp + (size_t)(16 * nt) * DM + ko); } }
                    asm volatile("s_waitcnt vmcnt(0)" ::: "memory"); __builtin_amdgcn_sched_barrier(0);
#pragma unroll
                    for (int s4 = 0; s4 < 4; ++s4)
#pragma unroll
                        for (int x = 0; x < 2; ++x) { const f32x4 a = xa[x][s4][0], b = xa[x][s4][1];
                            ss[x] += (a.x * a.x + a.y * a.y) + (a.z * a.z + a.w * a.w) + (b.x * b.x + b.y * b.y) + (b.z * b.z + b.w * b.w); }
                    __builtin_amdgcn_sched_barrier(0);
#pragma unroll
                    for (int s4 = 0; s4 < 4; ++s4)
#pragma unroll
                        for (int x = 0; x < 2; ++x) { const f32x4 a = xa[x][s4][0], b = xa[x][s4][1];
                            v4u h; h.x = cvt_pk_s(a.x, a.y); h.y = cvt_pk_s(a.z, a.w); h.z = cvt_pk_s(b.x, b.y); h.w = cvt_pk_s(b.z, b.w);
                            v4u l; l.x = cvt_pk_s(a.x - bf_lo(h.x), a.y - bf_hi(h.x)); l.y = cvt_pk_s(a.z - bf_lo(h.y), a.w - bf_hi(h.y));
                            l.z = cvt_pk_s(b.x - bf_lo(h.z), b.y - bf_hi(h.z)); l.w = cvt_pk_s(b.z - bf_lo(h.w), b.w - bf_hi(h.w));
                            const bf16x8 xh = __builtin_bit_cast(bf16x8, h), xl = __builtin_bit_cast(bf16x8, l);
#pragma unroll
                            for (int nt = 0; nt < 3; ++nt) {
                                acc[x][nt] = __builtin_amdgcn_mfma_f32_16x16x32_bf16(xl, bl[s4][nt], acc[x][nt], 0, 0, 0);
                                acc[x][nt] = __builtin_amdgcn_mfma_f32_16x16x32_bf16(xl, bh[s4][nt], acc[x][nt], 0, 0, 0);
                                acc[x][nt] = __builtin_amdgcn_mfma_f32_16x16x32_bf16(xh, bl[s4][nt], acc[x][nt], 0, 0, 0);
                                acc[x][nt] = __builtin_amdgcn_mfma_f32_16x16x32_bf16(xh, bh[s4][nt], acc[x][nt], 0, 0, 0); } }
                }
#pragma unroll
                for (int x = 0; x < 2; ++x) {
#pragma unroll
                    for (int nt = 0; nt < 3; ++nt)
#pragma unroll
                        for (int e = 0; e < 4; ++e) part[(wave * 32 + 16 * x + 4 * kg + e) * 48 + 16 * nt + li] = acc[x][nt][e];
                    float s1 = ss[x]; s1 += __shfl_xor(s1, 16); s1 += __shfl_xor(s1, 32);
                    if (kg == 0) ssp[wave * 32 + 16 * x + li] = s1; }
            }
            __syncthreads();
            for (int idx = tid; idx < 32 * 48; idx += 512) { float a = 0.f;
#pragma unroll
                for (int w8 = 0; w8 < 8; ++w8) a += part[w8 * 1536 + idx];
                logit[idx] = a; }
            if (tid < 32) { float a = 0.f;
#pragma unroll
                for (int w8 = 0; w8 < 8; ++w8) a += ssp[w8 * 32 + tid];
                const float r = __builtin_amdgcn_rsqf(a * (1.f / DM) + NORM_EPS); rsl[tid] = r; rstd_g[t0 + tid] = r; }
            __syncthreads();
            if (tid < 32) {
                const float rstd = rsl[tid]; const LAS float* lg = logit + tid * 48;
                int gidx = 0; float gmax = lg[0] * rstd + args.b_rg[0]; float glv[4]; glv[0] = gmax;
#pragma unroll
                for (int k = 1; k < 4; ++k) { glv[k] = lg[k] * rstd + args.b_rg[k]; if (glv[k] > gmax) { gmax = glv[k]; gidx = k; } }
                float gden = 0.f;
#pragma unroll
                for (int k = 0; k < 4; ++k) gden += __expf(glv[k] - gmax);
                const float gwt = 1.f / gden;
                int i0 = 0, i1 = -1; float v0 = -3.0e38f, v1 = -3.0e38f;
                for (int k = 0; k < 8; ++k) { const float v = lg[4 + 8 * gidx + k] * rstd + args.b_re[gidx * EPG + k];
                    if (v > v0) { v1 = v0; i1 = i0; v0 = v; i0 = k; } else if (v > v1) { v1 = v; i1 = k; } }
                const float p0 = 1.f / (1.f + __expf(v1 - v0)), p1 = 1.f - p0;
                selE[2 * tid] = gidx * EPG + i0; selE[2 * tid + 1] = gidx * EPG + i1; selW[2 * tid] = gwt * p0; selW[2 * tid + 1] = gwt * p1;
            }
            __syncthreads();
            if (wave == 0 && lane < NEXP) {
                const int e = lane; int cnt = 0;
                for (int i = 0; i < 64; ++i) cnt += (selE[i] == e) ? 1 : 0;
                unsigned base = 0u;
                if (cnt) base = __hip_atomic_fetch_add((unsigned*)(ctl + CW_CNT + 64 * e), (unsigned)cnt, RLX_AGENT);
                for (int i = 0; i < 64; ++i) if (selE[i] == e) { const int t = t0 + (i >> 1); ltok[e * SEQ + base] = t; lw[e * SEQ + base] = selW[i]; tokpos[2 * t + (i & 1)] = (e << 16) | (int)base; ++base; }
            }
            __syncthreads();
        }
        if (BOTH(4)) GRID_BAR();
    }

    if (IN(5) || IN(6) || IN(7)) {
        LAS int* mtok = (LAS int*)(lds + MOE_TOK_OFF); LAS float* mw = (LAS float*)(lds + MOE_W_OFF); LAS float* mr = (LAS float*)(lds + MOE_R_OFF); LAS int* tb = (LAS int*)(lds + MOE_TB_OFF);
        pg8::MoeOrder S{tb, G, bx};
        { const int tid = TID();
        if (tid == 0) { int acc = 0; for (int e = 0; e < NEXP; ++e) { const int c = (int)__hip_atomic_load((unsigned*)(ctl + CW_CNT + 64 * e), RLX_AGENT); tb[e] = acc; tb[33 + e] = c; acc += (c + 255) >> 8; } tb[32] = acc; }
        __syncthreads();
        for (int i = 0; i < MAXU; ++i) { pg8::Unit u; if (!S.next(i, u)) break;
            if (tid < 256) { const int idx = 256 * u.lt + tid; const bool valid = idx < tb[33 + u.e];
                const int tk = valid ? ltok[u.e * SEQ + idx] : -1;
                mtok[i * 256 + tid] = tk; mw[i * 256 + tid] = valid ? lw[u.e * SEQ + idx] : 0.f; mr[i * 256 + tid] = valid ? ((const float*)(ws + WS_RSTD))[tk] : 0.f; } }
        }
        __syncthreads();
        if (IN(5)) {
            pg8::Gemm g{XN, BTGU, DM / 2};
            pg8::EpiSwiGLU E{Hb, mw, mr};
            pg8::gemm_phase<pg8::EpiSwiGLU, pg8::MoeOrder, true, true, true>(lds, g, S, E, mtok, TID());
            {
                const int units = tb[32] * 8, rem = units % G, tailb = rem > 0 ? G - rem : G, ti = rem > 0 ? bx - rem : bx;
                if (ti >= 0) { const int lane = lane_id_v(); const int q = (CV_N5 + tailb * 8 - 1) / (tailb * 8), x0 = (ti * 8 + wave) * q, x1 = (x0 + q < CV_N5) ? x0 + q : CV_N5;
                    convert_range(args.w_gate, args.w_up, args.w_down, BTGU, BTD, CV_GU + CV_D - CV_N5 + x0, CV_GU + CV_D - CV_N5 + x1, lds + wave * 8448, lane); }
            }
            if (BOTH(5)) GRID_BAR();
        }
        if (IN(6)) {
            pg8::Gemm g{Hb, BTD, DFF / 2};
            pg8::EpiYStore E{Yb};
            pg8::gemm_phase<pg8::EpiYStore, pg8::MoeOrder, true, false, true>(lds, g, S, E, nullptr, TID());
            if (BOTH(6)) GRID_BAR();
        }
        if (IN(7)) {
            const int lane = lane_id_v();
            const int* tokpos = (const int*)(ws + WS_TOKPOS);
            for (int t = gw; t < SEQ; t += NGW) {
                const int c0 = tokpos[2 * t], c1 = tokpos[2 * t + 1];
                const size_t r0 = (size_t)(256 * tb[c0 >> 16] + (c0 & 0xffff)), r1 = (size_t)(256 * tb[c1 >> 16] + (c1 & 0xffff));
                const GAS f32x4* xo = (const GAS f32x4*)(args.out + (size_t)t * DM) + lane; GAS f32x4* xw = (GAS f32x4*)(args.out_w + (size_t)t * DM) + lane;
                const GAS v2u* y0 = (const GAS v2u*)(Yb + r0 * DM) + lane; const GAS v2u* y1 = (const GAS v2u*)(Yb + r1 * DM) + lane;
#pragma unroll
                for (int j = 0; j < 8; ++j) { f32x4 a = __builtin_nontemporal_load(xo + 64 * j); const v2u b0 = __builtin_nontemporal_load(y0 + 64 * j), b1 = __builtin_nontemporal_load(y1 + 64 * j);
                    a.x = (a.x + bf_lo(b0.x)) + bf_lo(b1.x); a.y = (a.y + bf_hi(b0.x)) + bf_hi(b1.x); a.z = (a.z + bf_lo(b0.y)) + bf_lo(b1.y); a.w = (a.w + bf_hi(b0.y)) + bf_hi(b1.y);
                    __builtin_nontemporal_store(a, xw + 64 * j); }
            }
        }
    }
#undef IN
#undef BOTH
#undef GRID_BAR
#undef TID
}

extern "C" void kernel_launch(void* const* d_in, const int* in_sizes, int n_in, void* d_out, int out_size, void* d_ws, size_t ws_size, hipStream_t stream) {
    static int grid = 0;
    if (grid == 0) {
        if (n_in != 19 || out_size != SEQ * DM || ws_size < WS_END) { fprintf(stderr, "kernel_launch: unexpected sizes (n_in %d out %d ws %zu)\n", n_in, out_size, ws_size); grid = -1; return; }
        int dev = 0, cus = 0, per_cu = 0;
        if (hipGetDevice(&dev) != hipSuccess || hipDeviceGetAttribute(&cus, hipDeviceAttributeMultiprocessorCount, dev) != hipSuccess) { grid = -1; return; }
        if (hipFuncSetAttribute((const void*)hymba_fwd, hipFuncAttributeMaxDynamicSharedMemorySize, LDS_BYTES) != hipSuccess) { fprintf(stderr, "kernel_launch: hipFuncSetAttribute failed\n"); grid = -1; return; }
        if (hipOccupancyMaxActiveBlocksPerMultiprocessor(&per_cu, (const void*)hymba_fwd, 512, LDS_BYTES) != hipSuccess || per_cu < 1) fprintf(stderr, "kernel_launch: occupancy query reports %d\n", per_cu);
        (void)hipGetLastError();
        grid = cus;
    }
    if (grid < 0) return;
    if (hipMemsetAsync((char*)d_ws + WS_CTL, 0, CTL_ZERO_BYTES, stream) != hipSuccess) return;
    Args a{};
    a.x = (const float*)d_in[0]; a.norm1_g = (const float*)d_in[1]; a.w_in = (const float*)d_in[2]; a.q_norm_g = (const float*)d_in[3]; a.k_norm_g = (const float*)d_in[4];
    a.conv_w = (const float*)d_in[5]; a.conv_b = (const float*)d_in[6]; a.conv_ln_g = (const float*)d_in[7]; a.conv_ln_b = (const float*)d_in[8]; a.rel_bias = (const float*)d_in[9];
    a.w_out = (const float*)d_in[10]; a.norm2_g = (const float*)d_in[11]; a.w_rg = (const float*)d_in[12]; a.b_rg = (const float*)d_in[13]; a.w_re = (const float*)d_in[14]; a.b_re = (const float*)d_in[15];
    a.w_gate = (const float*)d_in[16]; a.w_up = (const float*)d_in[17]; a.w_down = (const float*)d_in[18];
    a.out = (float*)d_out; a.out_w = (float*)d_out; a.ws = (unsigned char*)d_ws;
    if (N_LAUNCHES == 1) { a.ph_lo = 0; a.ph_hi = N_PHASES; hipLaunchKernelGGL(hymba_fwd, dim3(grid), dim3(512), LDS_BYTES, stream, a); }
    else {
#ifndef MK_PROBE
#define MK_PROBE -1
#endif
        for (int p = 0; p < N_PHASES; ++p) { a.ph_lo = p; a.ph_hi = p + 1; hipLaunchKernelGGL(hymba_fwd, dim3(grid), dim3(512), LDS_BYTES, stream, a);
            if (p == MK_PROBE) { Args b = a;
                if (p == 7) b.out_w = (float*)((char*)d_ws + WS_Q);
                if (p == 4) { b.ws = (unsigned char*)d_ws + 700 * MiB; (void)hipMemsetAsync(b.ws, 0, CTL_ZERO_BYTES, stream); }
                hipLaunchKernelGGL(hymba_fwd, dim3(grid), dim3(512), LDS_BYTES, stream, b); } }
    }
}
```

```cpp
#include <hip/hip_runtime.h>
#include <cstdio>
#include <cstdint>

#ifndef MK_N_LAUNCHES
#define MK_N_LAUNCHES 1
#endif
constexpr int N_LAUNCHES = MK_N_LAUNCHES;
constexpr int N_PHASES = 8;

#define GAS __attribute__((address_space(1)))
#define LAS __attribute__((address_space(3)))
typedef unsigned short bf16;
typedef unsigned v4u __attribute__((ext_vector_type(4)));
typedef unsigned v2u __attribute__((ext_vector_type(2)));
typedef float f32x4 __attribute__((ext_vector_type(4)));
typedef float f32x2 __attribute__((ext_vector_type(2)));
typedef short bf16x8 __attribute__((ext_vector_type(8)));
typedef short s16x4 __attribute__((ext_vector_type(4)));
typedef GAS unsigned gu32;
typedef int v8i __attribute__((ext_vector_type(8)));
typedef int v4i __attribute__((ext_vector_type(4)));
#define RLX_AGENT __ATOMIC_RELAXED, __HIP_MEMORY_SCOPE_AGENT
#define LDS_WAIT() asm volatile("s_waitcnt lgkmcnt(0)" ::: "memory")
#define VM_WAIT() asm volatile("s_waitcnt vmcnt(0)" ::: "memory")

constexpr int SEQ = 8192, DM = 2048, CCH = 1024, AW = 1024, NH = 16, HD = 64, INW = 5120, CONVW = 31;
constexpr int NGRP = 4, EPG = 8, NEXP = 32, DFF = 1024;
constexpr float NORM_EPS = 1e-6f;
constexpr float LOG2E = 1.4426950408889634f;
constexpr float C2 = 0.125f * LOG2E;
constexpr int MAXT = 96;
constexpr int MAXU = 3;

constexpr size_t MiB = 1u << 20;
constexpr size_t WS_CTL = 0, CTL_ZERO_BYTES = 40960;
constexpr size_t WS_LTOK = 1 * MiB;
constexpr size_t WS_LW = 2 * MiB;
constexpr size_t WS_BTIN = 4 * MiB;
constexpr size_t WS_BTOUT = 24 * MiB;
constexpr size_t WS_XN = 32 * MiB;
constexpr size_t WS_U = 64 * MiB;
constexpr size_t WS_Q = 80 * MiB, WS_K = 96 * MiB, WS_V = 112 * MiB;
constexpr size_t WS_MIX = 128 * MiB;
constexpr size_t WS_H = 160 * MiB;
constexpr size_t WS_BTGU = 208 * MiB;
constexpr size_t WS_BTD = 464 * MiB;
constexpr size_t WS_Y = 592 * MiB;
constexpr size_t WS_END = 688 * MiB;
constexpr size_t WS_TOKPOS = 3 * MiB;
constexpr size_t WS_RSTD = 3 * MiB + 65536;
constexpr size_t WS_WRH = 3 * MiB + 131072;
constexpr size_t WS_WRL = WS_WRH + 48 * 2048 * 2;
constexpr int CW_BAR = 0;
constexpr int CW_CNT = 4096;
static_assert((CW_CNT + 64 * 32) * 4 <= (int)CTL_ZERO_BYTES && 3456 <= CW_CNT, "control words inside the zeroed region");

constexpr int RING_BYTES = 131072;
constexpr int MOE_TOK_OFF = RING_BYTES;
constexpr int MOE_W_OFF = MOE_TOK_OFF + MAXU * 1024;
constexpr int MOE_R_OFF = MOE_W_OFF + MAXU * 1024;
constexpr int MOE_TB_OFF = MOE_R_OFF + MAXU * 1024;
constexpr int MISC_OFF = MOE_TB_OFF + 512;
constexpr int LDS_BYTES = 147456;
static_assert(MISC_OFF + 64 <= LDS_BYTES, "LDS map");

__device__ __forceinline__ unsigned f2bf(float f) { unsigned u = __builtin_bit_cast(unsigned, f); return (u + 0x7fffu + ((u >> 16) & 1u)) >> 16; }
__device__ __forceinline__ unsigned pk2(float lo, float hi) { return f2bf(lo) | (f2bf(hi) << 16); }
__device__ __forceinline__ unsigned cvt_pk_bf16(float lo, float hi) { unsigned r; asm volatile("v_cvt_pk_bf16_f32 %0, %1, %2" : "=v"(r) : "v"(lo), "v"(hi)); return r; }
typedef __bf16 bf16x2_t __attribute__((ext_vector_type(2)));
__device__ __forceinline__ unsigned cvt_pk_s(float lo, float hi) { const f32x2 v = {lo, hi}; const bf16x2_t b = __builtin_convertvector(v, bf16x2_t); return __builtin_bit_cast(unsigned, b); }
__device__ __forceinline__ unsigned pk4_fp8(float a, float b, float c, float d) { int p = 0; p = __builtin_amdgcn_cvt_pk_fp8_f32(a, b, p, false); p = __builtin_amdgcn_cvt_pk_fp8_f32(c, d, p, true); return (unsigned)p; }
constexpr float W8_SCALE = 64.f, H8_SCALE = 16.f;
__device__ __forceinline__ float bf_lo(unsigned u) { return __builtin_bit_cast(float, u << 16); }
__device__ __forceinline__ float bf_hi(unsigned u) { return __builtin_bit_cast(float, u & 0xffff0000u); }
__device__ __forceinline__ float sigmoidf_(float x) { return __builtin_amdgcn_rcpf(1.f + __expf(-x)); }
__device__ __forceinline__ int lane_id_v() { int l; asm volatile("v_mbcnt_lo_u32_b32 %0, -1, 0\n\tv_mbcnt_hi_u32_b32 %0, -1, %0" : "=v"(l)); return l; }
__device__ __forceinline__ float wave_sum(float v) {
#pragma unroll
    for (int o = 1; o < 64; o <<= 1) v += __shfl_xor(v, o);
    return v;
}

__constant__ unsigned char kBucket[3][132] = {
 {0,1,2,3,4,5,6,7,8,9,10,11,12,13,14,15,16,16,16,16,16,16,17,17,17,17,17,17,17,17,18,18,18,18,18,18,18,18,18,18,19,19,19,19,19,19,19,19,19,19,19,19,19,19,20,20,20,20,20,20,20,20,20,20,20,20,20,20,20,20,20,20,20,21,21,21,21,21,21,21,21,21,21,21,21,21,21,21,21,21,21,21,21,21,21,21,21,21,21,22,22,22,22,22,22,22,22,22,22,22,22,22,22,22,22,22,22,22,22,22,22,22,22,22,22,22,22,22,22,0,0,0},
 {0,4,8,12,16,16,17,17,18,18,19,19,19,19,20,20,20,20,20,21,21,21,21,21,21,22,22,22,22,22,22,22,22,22,23,23,23,23,23,23,23,23,23,23,23,23,24,24,24,24,24,24,24,24,24,24,24,24,24,24,24,24,25,25,25,25,25,25,25,25,25,25,25,25,25,25,25,25,25,25,25,25,25,26,26,26,26,26,26,26,26,26,26,26,26,26,26,26,26,26,26,26,26,26,26,26,26,26,26,26,26,26,26,27,27,27,27,27,27,27,27,27,27,27,27,27,27,27,27,0,0,0},
 {0,16,18,19,20,21,21,22,22,23,23,23,24,24,24,24,25,25,25,25,25,26,26,26,26,26,26,26,26,27,27,27,27,27,27,27,27,27,27,28,28,28,28,28,28,28,28,28,28,28,28,28,29,29,29,29,29,29,29,29,29,29,29,29,29,29,29,29,29,29,30,30,30,30,30,30,30,30,30,30,30,30,30,30,30,30,30,30,30,30,30,30,30,30,30,31,31,31,31,31,31,31,31,31,31,31,31,31,31,31,31,31,31,31,31,31,31,31,31,31,31,31,31,31,31,31,31,31,31,0,0,0}};

namespace pg8 {
constexpr int BM = 256, BK = 64, HALF = 128, HTB = HALF * BK * 2, STAGE_BYTES = 8 * HTB, NXCD = 8, WGM = 8;
__host__ __device__ __forceinline__ int lds_byte(int r, int c) { const int st = (r >> 4) * 2 + (c >> 5), rr = r & 15, cc = c & 31, ob = rr * 64 + cc * 2; return st * 1024 + (ob ^ (((ob >> 9) & 1) << 5)); }
__host__ __device__ __forceinline__ void stage_rc(int b, int& R, int& C) { const int st = b / 1024, sb = b % 1024, swz = sb ^ (((sb >> 9) & 1) << 5); R = (st >> 1) * 16 + swz / 64; C = (st & 1) * 32 + (swz % 64) / 2; }
__host__ __device__ __forceinline__ int perm32(int rho) { const int n = rho >> 4, i = rho & 15; return 8 * (i >> 2) + 4 * n + (i & 3); }

struct Unit { int pm, pn, e, lt, slot; };
struct Gemm { const bf16* A; const bf16* Bt; int K; };

struct StaticOrder {
    int nM, nN, nwg, G, c;
    __host__ __device__ void init(int M, int N, int G_, int c_) { nM = M / BM; nN = N / BM; nwg = nM * nN; G = G_; c = c_; }
    __host__ __device__ bool next(int i, Unit& u) const {
        const long L = (long)i * G + c; if (L >= nwg) return false;
        int wgid = (int)L; { const int q = nwg / NXCD, r = nwg % NXCD, xcd = wgid % NXCD, off = wgid / NXCD; wgid = (xcd < r ? xcd * (q + 1) : r * (q + 1) + (xcd - r) * q) + off; }
        const int nig = WGM * nN, gid = wgid / nig, fm = gid * WGM, gsz = (nM - fm) < WGM ? (nM - fm) : WGM;
        u.pm = fm + ((wgid % nig) % gsz); u.pn = (wgid % nig) / gsz; u.e = 0; u.lt = 0; u.slot = i; return true;
    }
};
struct MoeOrder {
    const LAS int* tb; int G, c;
    __device__ __forceinline__ bool next(int i, Unit& u) const {
        if (i >= MAXU) return false;
        const int T = __builtin_amdgcn_readfirstlane(tb[80 + 4 * i]); if (T < 0) return false;
        const int e = __builtin_amdgcn_readfirstlane(tb[81 + 4 * i]), n = __builtin_amdgcn_readfirstlane(tb[82 + 4 * i]);
        u.pm = T; u.pn = e * 8 + n; u.e = e; u.lt = __builtin_amdgcn_readfirstlane(tb[83 + 4 * i]); u.slot = i; return true;
    }
};

template <class Epi, class Sched, bool ALIGN_EPI, bool GATHER, bool F8 = false>
__device__ __forceinline__ void gemm_phase(LAS unsigned char* lds, const Gemm g, const Sched& S, const Epi& E, const LAS int* gtok, const int tid) {
    const int wid = __builtin_amdgcn_readfirstlane(tid >> 6), lane = tid & 63, wr = wid >> 2, wc = wid & 3, fr = lane & 15, fq = lane >> 4;
    const int K = g.K, nt = K / BK;
    const size_t kstep = (size_t)(BK * 2);
    const size_t hstep = (size_t)HALF * K * 2;
    const size_t tstep = 2 * hstep;
    unsigned voffB[2], vA[2][2];
#pragma unroll
    for (int i = 0; i < 2; ++i) { int R, C; stage_rc(tid * 16 + i * 8192, R, C); const int Rb = Epi::PERM ? ((R & ~31) + perm32(R & 31)) : R;
        voffB[i] = (unsigned)(Rb * K + C) * 2u;
        vA[0][i] = (unsigned)(R * K + C) * 2u; vA[1][i] = vA[0][i] + (unsigned)hstep; }
    const unsigned ldsw = (unsigned)wid * 1024u;
    const int aoff = lds_byte(wr * 64 + fr, fq * 8), boff = lds_byte(wc * 32 + fr, fq * 8);
#define PG8_SA(b, h) (((b) * 2 + (h)) * HTB)
#define PG8_SB(b, h) ((4 + (b) * 2 + (h)) * HTB)
#define PG8_STAGE(bufoff, gbase, voff) do { const char* _gb = (const char*)(gbase); asm volatile("" : "+s"(_gb)); _Pragma("unroll") for (int _i = 0; _i < 2; ++_i) { unsigned _vo = (voff)[_i]; asm volatile("" : "+v"(_vo)); \
        __builtin_amdgcn_global_load_lds((const unsigned*)(_gb + _vo), (LAS unsigned*)(lds + (bufoff) + ldsw + _i * 8192), 16, 0, 0); } } while (0)
#define PG8_GLOAD(v, slot_) do { const int _t = wid * 64 + lane_id_v(); _Pragma("unroll") for (int _i = 0; _i < 2; ++_i) { int _R, _C; stage_rc(_t * 16 + _i * 8192, _R, _C); \
        _Pragma("unroll") for (int _h = 0; _h < 2; ++_h) { int _tk = gtok[(slot_) * 256 + 128 * _h + _R]; _tk = _tk < 0 ? 0 : _tk; v[_h][_i] = (unsigned)(_tk * K + _C) * 2u; } } } while (0)
#define PG8_LDA(dst, b, h) do { if constexpr (F8) { _Pragma("unroll") for (int m = 0; m < 4; ++m) { const v4i _lo = *(const LAS v4i*)(lds + PG8_SA(b, h) + aoff + m * 2048), _hi = *(const LAS v4i*)(lds + PG8_SA(b, h) + aoff + m * 2048 + 1024); \
            dst##8[m] = __builtin_shufflevector(_lo, _hi, 0, 1, 2, 3, 4, 5, 6, 7); } } \
        else { _Pragma("unroll") for (int m = 0; m < 4; ++m) _Pragma("unroll") for (int k = 0; k < 2; ++k) dst[m][k] = *(const LAS bf16x8*)(lds + PG8_SA(b, h) + aoff + m * 2048 + k * 1024); } } while (0)
#define PG8_LDB(dst, b, h) do { if constexpr (F8) { _Pragma("unroll") for (int n = 0; n < 2; ++n) { const v4i _lo = *(const LAS v4i*)(lds + PG8_SB(b, h) + boff + n * 2048), _hi = *(const LAS v4i*)(lds + PG8_SB(b, h) + boff + n * 2048 + 1024); \
            dst##8[n] = __builtin_shufflevector(_lo, _hi, 0, 1, 2, 3, 4, 5, 6, 7); } } \
        else { _Pragma("unroll") for (int n = 0; n < 2; ++n) _Pragma("unroll") for (int k = 0; k < 2; ++k) dst[n][k] = *(const LAS bf16x8*)(lds + PG8_SB(b, h) + boff + n * 2048 + k * 1024); } } while (0)
#define PG8_MMA(ai, bj, At, Bt) do { __builtin_amdgcn_s_setprio(1); \
        if constexpr (F8) { _Pragma("unroll") for (int m = 0; m < 4; ++m) _Pragma("unroll") for (int n = 0; n < 2; ++n) \
            acc[ai][bj][m][n] = __builtin_amdgcn_mfma_scale_f32_16x16x128_f8f6f4(Bt##8[n], At##8[m], acc[ai][bj][m][n], 0, 0, 0, 0x7f7f7f7f, 0, 0x7f7f7f7f); } \
        else { _Pragma("unroll") for (int m = 0; m < 4; ++m) _Pragma("unroll") for (int n = 0; n < 2; ++n) _Pragma("unroll") for (int k = 0; k < 2; ++k) \
            acc[ai][bj][m][n] = __builtin_amdgcn_mfma_f32_16x16x32_bf16(Bt[n][k], At[m][k], acc[ai][bj][m][n], 0, 0, 0); } \
        __builtin_amdgcn_s_setprio(0); } while (0)
#define PG8_WAIT_V(n) asm volatile("s_waitcnt vmcnt(" #n ")" ::: "memory")
#define PG8_WAIT_L(n) asm volatile("s_waitcnt lgkmcnt(" #n ")" ::: "memory")
#define PG8_BAR __builtin_amdgcn_s_barrier()
#define PG8_SCHED __builtin_amdgcn_sched_barrier(0)
    Unit cur, nxt; int ui = 0;
    if (!S.next(0, cur)) return;
    f32x4 acc[2][2][4][2];
#pragma unroll
    for (int a = 0; a < 2; ++a)
#pragma unroll
        for (int b = 0; b < 2; ++b)
#pragma unroll
            for (int m = 0; m < 4; ++m)
#pragma unroll
                for (int n = 0; n < 2; ++n) acc[a][b][m][n] = (f32x4){0.f, 0.f, 0.f, 0.f};
    bf16x8 At[4][2], B0[2][2], B1[2][2]; v8i At8[4], B08[2], B18[2];
    const char* cA = GATHER ? (const char*)g.A : (const char*)g.A + (size_t)cur.pm * tstep; const char* cB = (const char*)g.Bt + (size_t)cur.pn * tstep;
    if constexpr (GATHER) { PG8_GLOAD(vA, cur.slot); }
    PG8_STAGE(PG8_SB(0, 0), cB, voffB); PG8_STAGE(PG8_SB(0, 1), cB + hstep, voffB); PG8_STAGE(PG8_SA(0, 0), cA, vA[0]); PG8_STAGE(PG8_SA(0, 1), cA, vA[1]);
    if (wr == 1) PG8_BAR;
    PG8_WAIT_V(2); PG8_BAR;
    PG8_STAGE(PG8_SB(1, 0), cB + kstep, voffB); PG8_STAGE(PG8_SA(1, 0), cA + kstep, vA[0]); PG8_STAGE(PG8_SB(1, 1), cB + hstep + kstep, voffB);
    PG8_WAIT_V(6); PG8_BAR;
    for (;;) {
        const bool has_next = S.next(ui + 1, nxt);
        const char* nA = GATHER ? cA : (has_next ? (const char*)g.A + (size_t)nxt.pm * tstep : cA); const char* nB = has_next ? (const char*)g.Bt + (size_t)nxt.pn * tstep : cB;

#pragma unroll 1
        for (int t = 0; t < nt; t += 2) {
            const bool last = (t == nt - 2);
            const char* a1 = cA + (size_t)(t + 1) * kstep;
            const char* a2 = last ? nA : cA + (size_t)(t + 2) * kstep; const char* b2 = last ? nB : cB + (size_t)(t + 2) * kstep;
            const char* a3 = a2 + kstep; const char* b3 = b2 + kstep;
            unsigned vS[2][2];
#pragma unroll
            for (int h = 0; h < 2; ++h)
#pragma unroll
                for (int i = 0; i < 2; ++i) vS[h][i] = vA[h][i];
            if constexpr (GATHER) { if (last && has_next) { PG8_GLOAD(vS, nxt.slot); } }

            PG8_LDB(B0, 0, 0); PG8_LDB(B1, 0, 1); PG8_SCHED; PG8_LDA(At, 0, 0); PG8_STAGE(PG8_SA(1, 1), a1, vA[1]);
            PG8_WAIT_V(8); PG8_WAIT_L(0); PG8_BAR; PG8_MMA(0, 0, At, B0); PG8_MMA(0, 1, At, B1); PG8_BAR; PG8_SCHED;
            PG8_LDA(At, 0, 1); PG8_STAGE(PG8_SB(0, 0), b2, voffB); PG8_STAGE(PG8_SB(0, 1), b2 + hstep, voffB); PG8_STAGE(PG8_SA(0, 0), a2, vS[0]);
            PG8_WAIT_V(8); PG8_WAIT_L(0); PG8_BAR; PG8_MMA(1, 0, At, B0); PG8_MMA(1, 1, At, B1); PG8_BAR; PG8_SCHED;
            PG8_LDB(B0, 1, 0); PG8_LDB(B1, 1, 1); PG8_SCHED; PG8_LDA(At, 1, 0); PG8_STAGE(PG8_SA(0, 1), a2, vS[1]);
            PG8_WAIT_V(8); PG8_WAIT_L(0); PG8_BAR; PG8_MMA(0, 0, At, B0); PG8_MMA(0, 1, At, B1); PG8_BAR; PG8_SCHED;
            PG8_LDA(At, 1, 1); PG8_STAGE(PG8_SB(1, 0), b3, voffB); PG8_STAGE(PG8_SB(1, 1), b3 + hstep, voffB); PG8_STAGE(PG8_SA(1, 0), a3, vS[0]);
            PG8_WAIT_V(8); PG8_WAIT_L(0); PG8_BAR; PG8_MMA(1, 0, At, B0); PG8_MMA(1, 1, At, B1); PG8_BAR; PG8_SCHED;
        }
        if constexpr (ALIGN_EPI) { if (wr == 0) PG8_BAR; }
        { const int _l = lane_id_v();
          E(acc, cur, wr, wc, _l & 15, _l >> 4); }
        if (!has_next) break;
#pragma unroll
        for (int a = 0; a < 2; ++a)
#pragma unroll
            for (int b = 0; b < 2; ++b)
#pragma unroll
                for (int m = 0; m < 4; ++m)
#pragma unroll
                    for (int n = 0; n < 2; ++n) acc[a][b][m][n] = (f32x4){0.f, 0.f, 0.f, 0.f};
        cur = nxt; cA = nA; cB = nB; ++ui;
        if constexpr (GATHER) { PG8_GLOAD(vA, cur.slot); }
        if constexpr (ALIGN_EPI) { if (wr == 1) PG8_BAR; }
    }
    PG8_WAIT_V(0);
    if constexpr (!ALIGN_EPI) { if (wr == 0) PG8_BAR; }
    PG8_BAR;
#undef PG8_SA
#undef PG8_SB
#undef PG8_STAGE
#undef PG8_GLOAD
#undef PG8_LDA
#undef PG8_LDB
#undef PG8_MMA
#undef PG8_WAIT_V
#undef PG8_WAIT_L
#undef PG8_BAR
#undef PG8_SCHED
}

typedef const f32x4 (&AccRef)[2][2][4][2];
struct EpiInProj {
    static constexpr bool PERM = true;
    bf16 *U, *Q, *Kb, *V; const float *qg, *kg;
    __device__ __forceinline__ void operator()(AccRef acc, const Unit& u, int wr, int wc, int fr, int fq) const {
        const int row0 = u.pm * BM + wr * 64 + fr;
        if (u.pn < 8) {
#pragma unroll
            for (int ai = 0; ai < 2; ++ai)
#pragma unroll
                for (int m = 0; m < 4; ++m) { const int r = row0 + ai * HALF + m * 16;
                    f32x4 a0 = acc[ai][0][m][0], a1 = acc[ai][0][m][1], g0 = acc[ai][1][m][0], g1 = acc[ai][1][m][1];
                    v4u w; w.x = cvt_pk_bf16(a0[0] * sigmoidf_(g0[0]), a0[1] * sigmoidf_(g0[1])); w.y = cvt_pk_bf16(a0[2] * sigmoidf_(g0[2]), a0[3] * sigmoidf_(g0[3]));
                    w.z = cvt_pk_bf16(a1[0] * sigmoidf_(g1[0]), a1[1] * sigmoidf_(g1[1])); w.w = cvt_pk_bf16(a1[2] * sigmoidf_(g1[2]), a1[3] * sigmoidf_(g1[3]));
                    *(v4u*)(U + (size_t)r * CCH + 128 * u.pn + 32 * wc + 8 * fq) = w; }
        } else if (u.pn < 16) {
            const int t = u.pn - 8, tensor = t >> 2, head = 4 * (t & 3) + wc;
            const float* gn = tensor ? kg : qg; bf16* dst = tensor ? Kb : Q; const float sc0 = tensor ? 1.f : C2;
            f32x4 gv[2][2];
#pragma unroll
            for (int bj = 0; bj < 2; ++bj)
#pragma unroll
                for (int n = 0; n < 2; ++n) gv[bj][n] = *(const f32x4*)(gn + 32 * bj + 8 * fq + 4 * n);
#pragma unroll
            for (int ai = 0; ai < 2; ++ai)
#pragma unroll
                for (int m = 0; m < 4; ++m) { const int r = row0 + ai * HALF + m * 16; float ss = 0.f;
#pragma unroll
                    for (int bj = 0; bj < 2; ++bj)
#pragma unroll
                        for (int n = 0; n < 2; ++n) { const f32x4 v = acc[ai][bj][m][n]; ss += (v[0] * v[0] + v[1] * v[1]) + (v[2] * v[2] + v[3] * v[3]); }
                    ss += __shfl_xor(ss, 16); ss += __shfl_xor(ss, 32);
                    const float sc = sc0 * __builtin_amdgcn_rsqf(ss * (1.f / 64.f) + NORM_EPS);
#pragma unroll
                    for (int bj = 0; bj < 2; ++bj) { const f32x4 v0 = acc[ai][bj][m][0] * gv[bj][0] * sc, v1 = acc[ai][bj][m][1] * gv[bj][1] * sc;
                        v4u w; w.x = cvt_pk_bf16(v0[0], v0[1]); w.y = cvt_pk_bf16(v0[2], v0[3]); w.z = cvt_pk_bf16(v1[0], v1[1]); w.w = cvt_pk_bf16(v1[2], v1[3]);
                        *(v4u*)(dst + (size_t)r * AW + 64 * head + 32 * bj + 8 * fq) = w; } }
        } else {
            const int cb = 256 * (u.pn - 16) + 32 * wc + 8 * fq;
#pragma unroll
            for (int ai = 0; ai < 2; ++ai)
#pragma unroll
                for (int m = 0; m < 4; ++m) { const int r = row0 + ai * HALF + m * 16;
#pragma unroll
                    for (int bj = 0; bj < 2; ++bj) { const f32x4 v0 = acc[ai][bj][m][0], v1 = acc[ai][bj][m][1];
                        v4u w; w.x = cvt_pk_bf16(v0[0], v0[1]); w.y = cvt_pk_bf16(v0[2], v0[3]); w.z = cvt_pk_bf16(v1[0], v1[1]); w.w = cvt_pk_bf16(v1[2], v1[3]);
                        *(v4u*)(V + (size_t)r * AW + cb + 128 * bj) = w; } }
        }
    }
};
struct EpiResF32 {
    static constexpr bool PERM = true;
    const float* X; float* O; bf16* HN; const float* g2;
    __device__ __forceinline__ void operator()(AccRef acc, const Unit& u, int wr, int wc, int fr, int fq) const {
        const int row0 = u.pm * BM + wr * 64 + fr, col0 = u.pn * BM + wc * 32 + 8 * fq;
        f32x4 gv[2][2];
#pragma unroll
        for (int bj = 0; bj < 2; ++bj)
#pragma unroll
            for (int n = 0; n < 2; ++n) gv[bj][n] = *(const f32x4*)(g2 + col0 + bj * HALF + 4 * n);
#pragma unroll
        for (int ai = 0; ai < 2; ++ai)
#pragma unroll
            for (int m = 0; m < 4; ++m) { const size_t ro = (size_t)(row0 + ai * HALF + m * 16) * DM + col0;
                f32x4 xv[2][2];
#pragma unroll
                for (int bj = 0; bj < 2; ++bj)
#pragma unroll
                    for (int n = 0; n < 2; ++n) xv[bj][n] = __builtin_nontemporal_load((const f32x4*)(X + ro + bj * HALF + 4 * n));
#pragma unroll
                for (int bj = 0; bj < 2; ++bj) { const f32x4 a = xv[bj][0] + acc[ai][bj][m][0], b = xv[bj][1] + acc[ai][bj][m][1];
                    *(f32x4*)(O + ro + bj * HALF) = a; *(f32x4*)(O + ro + bj * HALF + 4) = b;
                    const f32x4 ha = a * gv[bj][0], hb = b * gv[bj][1];
                    v2u w; w.x = pk4_fp8(ha[0], ha[1], ha[2], ha[3]); w.y = pk4_fp8(hb[0], hb[1], hb[2], hb[3]);
                    *(v2u*)((unsigned char*)HN + ro + bj * HALF) = w; } }
    }
};
struct EpiSwiGLU {
    static constexpr bool PERM = true;
    bf16* H; const LAS float* wts; const LAS float* rs;
    __device__ __forceinline__ void operator()(AccRef acc, const Unit& u, int wr, int wc, int fr, int fq) const {
        const int cb = 128 * (u.pn & 7) + 32 * wc + 8 * fq;
#pragma unroll
        for (int ai = 0; ai < 2; ++ai)
#pragma unroll
            for (int m = 0; m < 4; ++m) { const int R = ai * HALF + wr * 64 + m * 16 + fr; const float r = rs[u.slot * 256 + R] * (1.f / W8_SCALE), w = wts[u.slot * 256 + R] * r * H8_SCALE;
                const f32x4 g0 = acc[ai][0][m][0] * r, g1 = acc[ai][0][m][1] * r, u0 = acc[ai][1][m][0] * w, u1 = acc[ai][1][m][1] * w;
                v2u o; o.x = pk4_fp8(g0[0] * sigmoidf_(g0[0]) * u0[0], g0[1] * sigmoidf_(g0[1]) * u0[1], g0[2] * sigmoidf_(g0[2]) * u0[2], g0[3] * sigmoidf_(g0[3]) * u0[3]);
                o.y = pk4_fp8(g1[0] * sigmoidf_(g1[0]) * u1[0], g1[1] * sigmoidf_(g1[1]) * u1[1], g1[2] * sigmoidf_(g1[2]) * u1[2], g1[3] * sigmoidf_(g1[3]) * u1[3]);
                *(v2u*)((unsigned char*)H + (size_t)(u.pm * BM + R) * DFF + cb) = o; }
    }
};
struct EpiYStore {
    static constexpr bool PERM = true;
    bf16* Y;
    __device__ __forceinline__ void operator()(AccRef acc, const Unit& u, int wr, int wc, int fr, int fq) const {
        const int cb = 256 * (u.pn & 7) + 32 * wc + 8 * fq;
#pragma unroll
        for (int ai = 0; ai < 2; ++ai)
#pragma unroll
            for (int m = 0; m < 4; ++m) { const int R = ai * HALF + wr * 64 + m * 16 + fr;
#pragma unroll
                for (int bj = 0; bj < 2; ++bj) { const f32x4 v0 = acc[ai][bj][m][0] * (1.f / (W8_SCALE * H8_SCALE)), v1 = acc[ai][bj][m][1] * (1.f / (W8_SCALE * H8_SCALE));
                    v4u w; w.x = cvt_pk_bf16(v0[0], v0[1]); w.y = cvt_pk_bf16(v0[2], v0[3]); w.z = cvt_pk_bf16(v1[0], v1[1]); w.w = cvt_pk_bf16(v1[2], v1[3]);
                    *(v4u*)(Y + (size_t)(u.pm * BM + R) * DM + cb + 128 * bj) = w; } }
    }
};
struct EpiScatter {
    static constexpr bool PERM = false;
    float* O; const LAS int* toks;
    __device__ __forceinline__ void operator()(AccRef acc, const Unit& u, int wr, int wc, int fr, int fq) const {
        const int col0 = (u.pn & 7) * BM + wc * 32 + 4 * fq;
#pragma unroll
        for (int ai = 0; ai < 2; ++ai)
#pragma unroll
            for (int m = 0; m < 4; ++m) { const int R = ai * HALF + wr * 64 + m * 16 + fr; const int tok = toks[u.slot * 256 + R];
                if (tok >= 0) { float* ro = O + (size_t)tok * DM + col0;
#pragma unroll
                    for (int bj = 0; bj < 2; ++bj)
#pragma unroll
                        for (int n = 0; n < 2; ++n) { const f32x4 v = acc[ai][bj][m][n]; float* p = ro + bj * HALF + n * 16;
                            unsafeAtomicAdd(p + 0, v[0]); unsafeAtomicAdd(p + 1, v[1]); unsafeAtomicAdd(p + 2, v[2]); unsafeAtomicAdd(p + 3, v[3]); } } }
    }
};
}

#define XB_TMO      128
#define XB_XCNT(j)  (256  + 64 * (j))
#define XB_XSUB(j)  (1280 + 64 * (j))
#define XB_XGEN(j)  (2304 + 64 * (j))
#define XB_TOP      3328
#define XB_TOPGEN   3392
#define XCD_BAR_WORDS 3456
#define XB_SPIN_CAP (1u << 18)
__device__ __forceinline__ unsigned xb_ld(unsigned* p)              { return __hip_atomic_load(p, __ATOMIC_RELAXED, __HIP_MEMORY_SCOPE_AGENT); }
__device__ __forceinline__ unsigned xb_add(unsigned* p, unsigned v) { return __hip_atomic_fetch_add(p, v, __ATOMIC_RELAXED, __HIP_MEMORY_SCOPE_AGENT); }
__device__ __forceinline__ unsigned xb_xcc_id() { return (unsigned)__builtin_amdgcn_s_getreg((3 << 11) | 20) & 0xFu; }
#define XB_SPIN(cond, bar) do { unsigned _sp = 0; while (cond) { __builtin_amdgcn_s_sleep(1); \
    if ((++_sp & 255u) == 0u) { if (xb_ld(&(bar)[XB_TMO])) break; if (_sp > XB_SPIN_CAP) { atomicAdd(&(bar)[XB_TMO], 1u); break; } } } } while (0)
struct XcdBarrier { unsigned* bar; unsigned x; volatile LAS unsigned* st; };
__device__ __forceinline__ XcdBarrier xcd_barrier_post(unsigned* bar, volatile LAS unsigned* st, const int tid) {
    XcdBarrier b; b.bar = bar; b.x = xb_xcc_id(); b.st = st;
    if (tid == 0) (void)xb_add(&bar[XB_XCNT(b.x)], 1u);
    return b;
}
__device__ __forceinline__ void xcd_barrier_complete(unsigned* bar, unsigned x, unsigned& nloc, unsigned& nx) {
    const unsigned G = gridDim.x * gridDim.y * gridDim.z;
    unsigned sum, cnt, mine, sp = 0u;
    for (;;) {
        sum = 0u; cnt = 0u; mine = 0u;
#pragma unroll
        for (unsigned j = 0; j < 16; ++j) { const unsigned c = xb_ld(&bar[XB_XCNT(j)]); sum += c; cnt += (c > 0u) ? 1u : 0u; mine = (j == x) ? c : mine; }
        if (sum == G) break;
        __builtin_amdgcn_s_sleep(1);
        if ((++sp & 255u) == 0u) { if (xb_ld(&bar[XB_TMO])) break; if (sp > XB_SPIN_CAP) { atomicAdd(&bar[XB_TMO], 1u); break; } }
    }
    nloc = mine > 0u ? mine : 1u; nx = cnt > 0u ? cnt : 1u;
}
__device__ __forceinline__ void xcd_barrier(const XcdBarrier& b, const int tid) {
    asm volatile("s_waitcnt vmcnt(0)" ::: "memory");
    __syncthreads();
    if (tid == 0) {
        unsigned* bar = b.bar;
        __builtin_amdgcn_s_waitcnt(0);
        unsigned nloc = b.st[0], nx = b.st[1];
        if (nloc == 0u) { xcd_barrier_complete(bar, b.x, nloc, nx); b.st[0] = nloc; b.st[1] = nx; }
        const unsigned old = xb_add(&bar[XB_XSUB(b.x)], 1u);
        const unsigned gen = old / nloc;
        if (old + 1u == (gen + 1u) * nloc) {
            __builtin_amdgcn_fence(__ATOMIC_RELEASE, "agent");
            asm volatile("s_waitcnt vmcnt(0)" ::: "memory");
            const unsigned og = xb_add(&bar[XB_TOP], 1u);
            const unsigned tg = og / nx;
            if (og + 1u == (tg + 1u) * nx) xb_add(&bar[XB_TOPGEN], 1u);
            else XB_SPIN(xb_ld(&bar[XB_TOPGEN]) == tg, bar);
            __builtin_amdgcn_fence(__ATOMIC_ACQUIRE, "agent");
            xb_add(&bar[XB_XGEN(b.x)], 1u);
            asm volatile("s_waitcnt vmcnt(0)" ::: "memory");
        } else {
            XB_SPIN(xb_ld(&bar[XB_XGEN(b.x)]) == gen, bar);
            __builtin_amdgcn_fence(__ATOMIC_ACQUIRE, "agent");
            asm volatile("s_waitcnt vmcnt(0)" ::: "memory");
        }
    }
    __syncthreads();
}

struct Args {
    const float *x, *norm1_g, *w_in, *q_norm_g, *k_norm_g, *conv_w, *conv_b, *conv_ln_g, *conv_ln_b, *rel_bias, *w_out, *norm2_g, *w_rg, *b_rg, *w_re, *b_re, *w_gate, *w_up, *w_down;
    float* out; float* out_w; unsigned char* ws; int ph_lo, ph_hi;
};

__device__ __forceinline__ void transpose_item(const float* Wsrc, int ldw, bf16* dst, int ldd, LAS float* scr, int lane) {
    const float* p = Wsrc + (size_t)(lane >> 5) * ldw + (lane & 31);
#pragma unroll 1
    for (int hh = 0; hh < 2; ++hh) {
        float tv[16];
#pragma unroll
        for (int i = 0; i < 16; ++i) { tv[i] = *p; p += 2 * ldw; }
#pragma unroll
        for (int i = 0; i < 16; ++i) { const int kk = 2 * (16 * hh + i) + (lane >> 5); scr[kk * 33 + (lane & 31)] = tv[i]; }
    }
    LDS_WAIT(); asm volatile("" ::: "memory");
    const int c = lane & 7;
#pragma unroll
    for (int j = 0; j < 4; ++j) { const int n = (lane >> 3) + 8 * j; const LAS float* s = scr + (8 * c) * 33 + n;
        v4u o; o.x = pk2(s[0 * 33], s[1 * 33]); o.y = pk2(s[2 * 33], s[3 * 33]); o.z = pk2(s[4 * 33], s[5 * 33]); o.w = pk2(s[6 * 33], s[7 * 33]);
        *(GAS v4u*)(dst + (size_t)n * ldd + 8 * c) = o; }
    LDS_WAIT(); asm volatile("" ::: "memory");
}
__device__ __forceinline__ void t64_load(const float* Wsrc, int ldw, int lane, f32x4 (&tv)[16]) {
    const float* p = Wsrc + (size_t)(lane >> 3) * ldw + 4 * (lane & 7);
#pragma unroll
    for (int i = 0; i < 16; ++i) { tv[i] = __builtin_nontemporal_load((const f32x4*)p); p += 8 * ldw; }
}
__device__ __forceinline__ void t64_finish(const f32x4 (&tv)[16], unsigned char* dst, int ldd, int f8, LAS unsigned char* scr, int lane) {
    const int g = lane >> 4, i16 = lane & 15;
#pragma unroll
    for (int i = 0; i < 16; ++i) { v2u w; w.x = cvt_pk_bf16(tv[i].x, tv[i].y); w.y = cvt_pk_bf16(tv[i].z, tv[i].w); *(LAS v2u*)(scr + (8 * i + (lane >> 3)) * 64 + 8 * (lane & 7)) = w; }
    LDS_WAIT(); asm volatile("" ::: "memory");
    const int q = i16 >> 2, pp = i16 & 3;
    bf16x8 o[8];
#pragma unroll
    for (int jj = 0; jj < 8; ++jj) { const int c = 4 * jj + g, nb = c & 1, kg = c >> 1;
        LAS unsigned char* ra = scr + (8 * kg + q) * 64 + 32 * nb + 8 * pp;
        const s16x4 lo = __builtin_bit_cast(s16x4, __builtin_amdgcn_ds_read_tr16_b64_v4i16((LAS s16x4*)ra));
        const s16x4 hi = __builtin_bit_cast(s16x4, __builtin_amdgcn_ds_read_tr16_b64_v4i16((LAS s16x4*)(ra + 4 * 64)));
        o[jj] = __builtin_shufflevector(lo, hi, 0, 1, 2, 3, 4, 5, 6, 7); }
    LDS_WAIT(); asm volatile("" ::: "memory");
#pragma unroll
    for (int jj = 0; jj < 8; ++jj) { const int c = 4 * jj + g, nb = c & 1, kg = c >> 1; const int n = 16 * nb + i16;
        *(LAS bf16x8*)(scr + n * 256 + 16 * (kg ^ (n & 15))) = o[jj]; }
    LDS_WAIT(); asm volatile("" ::: "memory");
    const int rr = lane >> 3, cc = lane & 7;
#pragma unroll
    for (int it = 0; it < 4; ++it) { const int n = 8 * it + rr;
        const v4u v0 = *(const LAS v4u*)(scr + n * 256 + 16 * ((2 * cc) ^ (n & 15))), v1 = *(const LAS v4u*)(scr + n * 256 + 16 * ((2 * cc + 1) ^ (n & 15)));
        if (f8) { v4u o4; o4.x = pk4_fp8(bf_lo(v0.x) * W8_SCALE, bf_hi(v0.x) * W8_SCALE, bf_lo(v0.y) * W8_SCALE, bf_hi(v0.y) * W8_SCALE);
            o4.y = pk4_fp8(bf_lo(v0.z) * W8_SCALE, bf_hi(v0.z) * W8_SCALE, bf_lo(v0.w) * W8_SCALE, bf_hi(v0.w) * W8_SCALE);
            o4.z = pk4_fp8(bf_lo(v1.x) * W8_SCALE, bf_hi(v1.x) * W8_SCALE, bf_lo(v1.y) * W8_SCALE, bf_hi(v1.y) * W8_SCALE);
            o4.w = pk4_fp8(bf_lo(v1.z) * W8_SCALE, bf_hi(v1.z) * W8_SCALE, bf_lo(v1.w) * W8_SCALE, bf_hi(v1.w) * W8_SCALE);
            __builtin_nontemporal_store(o4, (GAS v4u*)(dst + (size_t)n * ldd + 16 * cc)); }
        else { *(GAS v4u*)(dst + (size_t)n * ldd + 32 * cc) = v0; *(GAS v4u*)(dst + (size_t)n * ldd + 32 * cc + 16) = v1; } }
    LDS_WAIT(); asm volatile("" ::: "memory");
}
__device__ __forceinline__ int win_src_col(int n0) {
    const int pn = n0 >> 8, j = n0 & 255;
    if (pn < 8) return ((j >> 7) ? CCH : 0) + 128 * pn + (j & 127);
    if (pn < 16) { const int t = pn - 8, tensor = t >> 2, head = 4 * (t & 3) + ((j >> 5) & 3), dim = 32 * (j >> 7); return 2 * CCH + AW * tensor + 64 * head + dim; }
    return 2 * CCH + 2 * AW + 256 * (pn - 16) + j;
}
__device__ __forceinline__ void rms_row_to_bf16(const float* xrow, const float* g, bf16* orow, int lane) {
    const GAS f32x4* xr = (const GAS f32x4*)xrow + lane; const GAS f32x4* gr = (const GAS f32x4*)g + lane;
    f32x4 v[8]; float s = 0.f;
#pragma unroll
    for (int j = 0; j < 8; ++j) { v[j] = xr[64 * j]; s += (v[j].x * v[j].x + v[j].y * v[j].y) + (v[j].z * v[j].z + v[j].w * v[j].w); }
    const float rstd = __builtin_amdgcn_rsqf(wave_sum(s) * (1.f / DM) + NORM_EPS);
    GAS v2u* o8 = (GAS v2u*)orow + lane;
#pragma unroll
    for (int j = 0; j < 8; ++j) { const f32x4 gg = gr[64 * j]; v2u w; w.x = pk2(v[j].x * rstd * gg.x, v[j].y * rstd * gg.y); w.y = pk2(v[j].z * rstd * gg.z, v[j].w * rstd * gg.w); o8[64 * j] = w; }
}

template <int P, int NT>
__device__ __forceinline__ void attn_pattern(const bf16* __restrict__ Kh, const bf16* __restrict__ Vh, const int t0, LAS unsigned char* vbuf, const LAS float* bt,
                                             const bf16x8 (&qf)[NT][2], f32x4 (&o)[NT][4], f32x4 (&lacc)[NT], int lane) {
    constexpr int DL = (P == 0) ? 1 : (P == 1) ? 4 : 16, SQ = 16 / DL, GS = 3, NGRPS = (P == 0) ? 4 : 2;
    constexpr int SH = 8 / DL;
    static_assert(NT == 1 || P < 2, "tile pairs share keys only for dilation 1 and 4");
    const int qi = lane & 15, g = lane >> 4, q4 = qi >> 2, pp = qi & 3;
    const int xr = (2 * g + (q4 >> 1)) & 3;
    unsigned tra[4];
#pragma unroll
    for (int dt = 0; dt < 4; ++dt) tra[dt] = (unsigned)((4 * g + q4) * 128 + 32 * (dt ^ xr) + 8 * pp);
    unsigned klo[2], vlo[4], vwa[4];
#pragma unroll
    for (int tt = 0; tt < 2; ++tt) klo[tt] = (unsigned)(DL * (16 * tt + qi) * AW + 8 * g);
#pragma unroll
    for (int k = 0; k < 4; ++k) { const int idx = lane + 64 * k, row = idx >> 3, c16 = idx & 7; vlo[k] = (unsigned)(DL * row * AW + 8 * c16); vwa[k] = (unsigned)(row * 128 + 16 * (c16 ^ (((row >> 1) & 3) << 1))); }
    const int tq = t0 / DL;
    unsigned relmax[NT];
#pragma unroll
    for (int x = 0; x < NT; ++x) { const int m = SQ * qi + tq + x * SH; relmax[x] = (unsigned)(m < 128 ? m : 128); }
    const int relb = 128 + SQ * qi - 4 * g;
    const bf16x8 ones = (bf16x8){0x3f80, 0x3f80, 0x3f80, 0x3f80, 0x3f80, 0x3f80, 0x3f80, 0x3f80};
#pragma unroll 1
    for (int grp = 0; grp < NGRPS; ++grp) {
        bf16x8 kfg[GS][2][2]; v4u vrg[GS][4];
#pragma unroll
        for (int s3 = 0; s3 < GS; ++s3) { if (P == 2 && GS * grp + s3 >= 5) break;
            const long ro = ((long)t0 + DL * (32 * (GS * grp + s3) - 128)) * AW; const bf16* kb = Kh + ro; const bf16* vbs = Vh + ro;
#pragma unroll
            for (int tt = 0; tt < 2; ++tt) { kfg[s3][tt][0] = *(const bf16x8*)(kb + klo[tt]); kfg[s3][tt][1] = *(const bf16x8*)(kb + klo[tt] + 32); }
#pragma unroll
            for (int k = 0; k < 4; ++k) vrg[s3][k] = *(const v4u*)(vbs + vlo[k]); }
#pragma unroll
        for (int s3 = 0; s3 < GS; ++s3) {
            const int c = GS * grp + s3;
            if (P == 2 && c >= 5) break;
            LAS unsigned char* vb = vbuf + s3 * 4096;
#pragma unroll
            for (int k = 0; k < 4; ++k) *(LAS v4u*)(vb + vwa[k]) = vrg[s3][k];
            const int rel0 = relb - 32 * c;
            bf16x8 pf[NT];
#pragma unroll
            for (int x = 0; x < NT; ++x) {
                f32x4 sc[2];
#pragma unroll
                for (int tt = 0; tt < 2; ++tt) { f32x4 z = (f32x4){0.f, 0.f, 0.f, 0.f};
                    z = __builtin_amdgcn_mfma_f32_16x16x32_bf16(kfg[s3][tt][0], qf[x][0], z, 0, 0, 0);
                    sc[tt] = __builtin_amdgcn_mfma_f32_16x16x32_bf16(kfg[s3][tt][1], qf[x][1], z, 0, 0, 0); }
                const LAS float* btp = bt + (rel0 + x * SH - 19);
                float p[2][4];
#pragma unroll
                for (int tt = 0; tt < 2; ++tt)
#pragma unroll
                    for (int e = 0; e < 4; ++e) { const int rel = rel0 + x * SH - 16 * tt - e;
                        const float pe = __builtin_amdgcn_exp2f(sc[tt][e] + btp[19 - 16 * tt - e]);
                        p[tt][e] = ((unsigned)rel <= relmax[x]) ? pe : 0.f; }
                v4u pw; pw.x = cvt_pk_s(p[0][0], p[0][1]); pw.y = cvt_pk_s(p[0][2], p[0][3]); pw.z = cvt_pk_s(p[1][0], p[1][1]); pw.w = cvt_pk_s(p[1][2], p[1][3]);
                pf[x] = __builtin_bit_cast(bf16x8, pw);
                lacc[x] = __builtin_amdgcn_mfma_f32_16x16x32_bf16(ones, pf[x], lacc[x], 0, 0, 0);
            }
#pragma unroll
            for (int dt = 0; dt < 4; ++dt) {
                const s16x4 lo = __builtin_bit_cast(s16x4, __builtin_amdgcn_ds_read_tr16_b64_v4i16((LAS s16x4*)(vb + tra[dt])));
                const s16x4 hi = __builtin_bit_cast(s16x4, __builtin_amdgcn_ds_read_tr16_b64_v4i16((LAS s16x4*)(vb + tra[dt] + 2048)));
                const bf16x8 vf = __builtin_shufflevector(lo, hi, 0, 1, 2, 3, 4, 5, 6, 7);
#pragma unroll
                for (int x = 0; x < NT; ++x) o[x][dt] = __builtin_amdgcn_mfma_f32_16x16x32_bf16(vf, pf[x], o[x][dt], 0, 0, 0);
            }
        }
    }
}

__device__ __forceinline__ void attn_wave(const bf16* Q, const bf16* Kb, const bf16* Vb, bf16* MIX, int h, const int t0, LAS unsigned char* vbuf, const LAS float* bt, int lane) {
    asm volatile("" : "+v"(lane));
    const int qi = lane & 15, g = lane >> 4;
    bf16x8 qf[2][2]; f32x4 o[2][4]; f32x4 lacc[2];
#pragma unroll
    for (int x = 0; x < 2; ++x) { const bf16* qrow = Q + (size_t)(t0 + 8 * x + 16 * qi) * AW + 64 * h + 8 * g; qf[x][0] = *(const bf16x8*)qrow; qf[x][1] = *(const bf16x8*)(qrow + 32);
        lacc[x] = (f32x4){0.f, 0.f, 0.f, 0.f};
#pragma unroll
        for (int dt = 0; dt < 4; ++dt) o[x][dt] = (f32x4){0.f, 0.f, 0.f, 0.f}; }
    const bf16* Kh = Kb + 64 * h; const bf16* Vh = Vb + 64 * h;
    attn_pattern<0, 2>(Kh, Vh, t0, vbuf, bt, qf, o, lacc, lane);
    attn_pattern<1, 2>(Kh, Vh, t0, vbuf, bt + 132, qf, o, lacc, lane);
#pragma unroll
    for (int x = 0; x < 2; ++x) {
        bf16x8 q1[1][2] = {{qf[x][0], qf[x][1]}}; f32x4 o1[1][4] = {{o[x][0], o[x][1], o[x][2], o[x][3]}}; f32x4 l1[1] = {lacc[x]};
        attn_pattern<2, 1>(Kh, Vh, t0 + 8 * x, vbuf, bt + 264, q1, o1, l1, lane);
        const float inv = 1.f / l1[0][0];
        bf16* orow = MIX + (size_t)(t0 + 8 * x + 16 * qi) * DM + CCH + 64 * h + 4 * g;
#pragma unroll
        for (int dt = 0; dt < 4; ++dt) { v2u w; w.x = cvt_pk_bf16(o1[0][dt][0] * inv, o1[0][dt][1] * inv); w.y = cvt_pk_bf16(o1[0][dt][2] * inv, o1[0][dt][3] * inv); *(v2u*)(orow + 16 * dt) = w; }
    }
}

constexpr int CV_IN = (DM / 64) * (INW / 32), CV_OUT = (DM / 64) * (DM / 32), CV_GU = NEXP * 2 * (DM / 128) * (DFF / 32), CV_D = NEXP * (DFF / 128) * (DM / 32);
constexpr int CV_SMALL = CV_IN + CV_OUT, CV_ALL = CV_SMALL + CV_GU + CV_D;
constexpr int P1_ROUNDS = 4;
constexpr int CV_N1 = 28672, CV_N5 = 4096;
__device__ __forceinline__ void convert_item(const float* w_in, const float* w_out, int r, bf16* BTIN, bf16* BTOUT, LAS float* scr, int lane) {
    if (r < CV_IN) { const int nblk = INW / 32, kb = r / nblk, nb = r % nblk; transpose_item(w_in + (size_t)(64 * kb) * INW + win_src_col(32 * nb), INW, BTIN + (size_t)(32 * nb) * DM + 64 * kb, DM, scr, lane); return; }
    r -= CV_IN;
    { const int nblk = DM / 32, kb = r / nblk, nb = r % nblk; transpose_item(w_out + (size_t)(64 * kb) * DM + 32 * nb, DM, BTOUT + (size_t)(32 * nb) * DM + 64 * kb, DM, scr, lane); }
}
struct XItem { const float* src; unsigned char* dst; int ldw, ldd, f8; };
__device__ __forceinline__ XItem xitem(const float* w_gate, const float* w_up, const float* w_down, bf16* BTGU, bf16* BTD, int r) {
    XItem it;
    if (r < CV_GU) { const int per = (DM / 128) * (DFF / 32); const int e = r / (2 * per), r2 = r % (2 * per), which = r2 / per, r3 = r2 % per; const int nblk = DFF / 32, kb = r3 / nblk, nb = r3 % nblk;
        const float* W = (which ? w_up : w_gate) + (size_t)e * DM * DFF;
        const int f0 = 32 * nb, brow = 256 * (f0 >> 7) + 128 * which + (f0 & 127);
        it.src = W + (size_t)(128 * kb) * DFF + f0; it.ldw = DFF; it.dst = (unsigned char*)BTGU + ((size_t)e * 2048 + brow) * DM + 128 * kb; it.ldd = DM; it.f8 = 1; return it; }
    r -= CV_GU;
    { const int per = (DFF / 128) * (DM / 32); const int e = r / per, r3 = r % per; const int nblk = DM / 32, kb = r3 / nblk, nb = r3 % nblk;
        it.src = w_down + (size_t)e * DFF * DM + (size_t)(128 * kb) * DM + 32 * nb; it.ldw = DM; it.dst = (unsigned char*)BTD + ((size_t)e * DM + 32 * nb) * DFF + 128 * kb; it.ldd = DFF; it.f8 = 1; return it; }
}
__device__ __forceinline__ void convert_range(const float* w_gate, const float* w_up, const float* w_down, bf16* BTGU, bf16* BTD, int x0, int x1, LAS unsigned char* scr, int lane) {
    if (x0 >= x1) return;
    f32x4 ta[16], tc[16];
    XItem A = xitem(w_gate, w_up, w_down, BTGU, BTD, x0), B = A;
    t64_load(A.src, A.ldw, lane, ta);
#pragma unroll 1
    for (int x = x0; x < x1; x += 2) {
        const bool hasB = x + 1 < x1;
        if (hasB) { B = xitem(w_gate, w_up, w_down, BTGU, BTD, x + 1); t64_load(B.src, B.ldw, lane, tc); }
        t64_finish(ta, A.dst, A.ldd, A.f8, scr, lane);
        if (hasB) {
            if (x + 2 < x1) { A = xitem(w_gate, w_up, w_down, BTGU, BTD, x + 2); t64_load(A.src, A.ldw, lane, ta); }
            t64_finish(tc, B.dst, B.ldd, B.f8, scr, lane);
        }
    }
}

__global__ void __launch_bounds__(512, 2) hymba_fwd(Args args) {
    extern __shared__ __attribute__((aligned(16))) unsigned char lds_raw[];
    LAS unsigned char* lds = (LAS unsigned char*)lds_raw;
    const int wave = __builtin_amdgcn_readfirstlane(threadIdx.x >> 6);
#define TID() (wave * 64 + lane_id_v())
    const int G = gridDim.x, bx = blockIdx.x;
    unsigned char* ws = args.ws;
    gu32* ctl = (gu32*)(ws + WS_CTL);
    int* ltok = (int*)(ws + WS_LTOK); float* lw = (float*)(ws + WS_LW);
    bf16* BTIN = (bf16*)(ws + WS_BTIN); bf16* BTOUT = (bf16*)(ws + WS_BTOUT); bf16* XN = (bf16*)(ws + WS_XN); bf16* Ub = (bf16*)(ws + WS_U);
    bf16* Qb = (bf16*)(ws + WS_Q); bf16* Kb = (bf16*)(ws + WS_K); bf16* Vb = (bf16*)(ws + WS_V); bf16* MIX = (bf16*)(ws + WS_MIX); bf16* Hb = (bf16*)(ws + WS_H);
    bf16* BTGU = (bf16*)(ws + WS_BTGU); bf16* BTD = (bf16*)(ws + WS_BTD); bf16* Yb = (bf16*)(ws + WS_Y);
    volatile LAS unsigned* MISC = (volatile LAS unsigned*)(lds + MISC_OFF);
    { const int tid = TID(); if (tid < 16) MISC[tid] = 0u; }
    __syncthreads();
    XcdBarrier bar; bar.bar = (unsigned*)(ctl + CW_BAR); bar.x = 0; bar.st = nullptr;
    if (N_LAUNCHES == 1) bar = xcd_barrier_post((unsigned*)(ctl + CW_BAR), MISC, TID());
    const int lo = args.ph_lo, hi = args.ph_hi;
#define IN(k) (lo <= (k) && (k) < hi)
#define BOTH(k) (IN(k) && IN((k) + 1))
#define GRID_BAR() xcd_barrier(bar, TID())
    const int gw = bx * 8 + wave, NGW = G * 8;

    if (IN(0)) {
        const int lane = lane_id_v();
        LAS float* scr = (LAS float*)(lds + wave * 16384);
        for (int it = gw; it < CV_SMALL; it += NGW) convert_item(args.w_in, args.w_out, it, BTIN, BTOUT, scr, lane);
        for (int m = gw; m < SEQ; m += NGW) rms_row_to_bf16(args.x + (size_t)m * DM, args.norm1_g, XN + (size_t)m * DM, lane);
        {
            bf16* WRH = (bf16*)(ws + WS_WRH); bf16* WRL = (bf16*)(ws + WS_WRL);
            for (int idx = gw * 64 + lane; idx < 48 * DM; idx += NGW * 64) { const int j = idx / DM, d = idx % DM;
                float w = 0.f;
                if (j < 4) w = args.w_rg[d * NGRP + j]; else if (j < 36) w = args.w_re[((size_t)((j - 4) >> 3) * DM + d) * EPG + ((j - 4) & 7)];
                w *= args.norm2_g[d];
                const unsigned hi = f2bf(w); const float rem = w - __builtin_bit_cast(float, hi << 16);
                WRH[idx] = (bf16)hi; WRL[idx] = (bf16)f2bf(rem); }
        }
        if (BOTH(0)) GRID_BAR();
    }

    if (IN(1)) {
        const int units = (SEQ / 256) * (INW / 256), GG = (G >= 256) ? (units + P1_ROUNDS - 1) / P1_ROUNDS : G, FB = G - GG;
        if (bx < GG) {
            pg8::Gemm g{XN, BTIN, DM}; pg8::StaticOrder S; S.init(SEQ, INW, GG, bx);
            pg8::EpiInProj E{Ub, Qb, Kb, Vb, args.q_norm_g, args.k_norm_g};
            pg8::gemm_phase<pg8::EpiInProj, pg8::StaticOrder, true, false>(lds, g, S, E, nullptr, TID());
        }
        {   const int lane = lane_id_v();
            const int nb = FB > 0 ? FB : G, ti = FB > 0 ? bx - GG : bx;
            if (ti >= 0) { const int q = (CV_N1 + nb * 8 - 1) / (nb * 8), x0 = (ti * 8 + wave) * q, x1 = (x0 + q < CV_N1) ? x0 + q : CV_N1;
                convert_range(args.w_gate, args.w_up, args.w_down, BTGU, BTD, x0, x1, lds + wave * 8448, lane); }
        }
        if (BOTH(1)) GRID_BAR();
    }

    if (IN(2)) {
        LAS float* btab = (LAS float*)(lds + 8 * 12288);
        const int tid = TID(), lane = tid & 63;
        {
            float mq = 0.f, mk = 0.f;
            for (int d = 0; d < HD; ++d) { mq = fmaxf(mq, fabsf(args.q_norm_g[d])); mk = fmaxf(mk, fabsf(args.k_norm_g[d])); }
            for (int idx = tid; idx < NH * 3 * 132; idx += 512) { const int h = idx / 396, r2 = idx % 396, p = r2 / 132, rel = r2 % 132;
                float mb = 0.f; for (int b = 0; b < 32; ++b) mb = fmaxf(mb, fabsf(args.rel_bias[b * NH + h]));
                const float Mh = 1.02f * C2 * 64.f * mq * mk + mb * LOG2E;
                btab[idx] = args.rel_bias[(int)kBucket[p][rel] * NH + h] * LOG2E - Mh; }
        }
        __syncthreads();
        LAS unsigned char* vbuf = lds + wave * 12288;
        {
            constexpr int CV_LO = CV_N1, CV_HI = CV_GU + CV_D - CV_N5, CV_EXP = CV_HI - CV_LO;
            const int nA = (512 - bx + G - 1) / G;
            const int per_wave = (CV_EXP + NGW - 1) / NGW;
            const int c_lo = CV_LO + gw * per_wave, c_hi = (c_lo + per_wave < CV_HI) ? c_lo + per_wave : CV_HI;
            const int nsteps = nA > 0 ? nA : 1, per_batch = (per_wave + nsteps - 1) / nsteps;
            int ia = 0, ic = c_lo;
#pragma unroll 1
            for (int hs = 0; hs < 2 * nsteps; ++hs) {
                const bool doA = (((hs & 1) == 0) == (wave < 4));
                if (doA) { if (ia < nA) { const int a = bx + ia * G; const int blk = a >> 4, h = a & 15;
                        attn_wave(Qb, Kb, Vb, MIX, h, 256 * blk + wave, vbuf, btab + h * 396, lane); ++ia; } }
                else { const int ce = (ic + per_batch < c_hi) ? ic + per_batch : c_hi;
                    convert_range(args.w_gate, args.w_up, args.w_down, BTGU, BTD, ic, ce, vbuf, lane); ic = ce > ic ? ce : ic; }
            }
            convert_range(args.w_gate, args.w_up, args.w_down, BTGU, BTD, ic, c_hi, vbuf, lane);
        }
        __syncthreads();
        LAS float* cv = (LAS float*)lds;
        for (int ct = bx; ct < SEQ / 32; ct += G) {
            const int tb0 = 32 * ct, c0 = 2 * tid;
            float w0[CONVW], w1[CONVW];
#pragma unroll
            for (int j = 0; j < CONVW; ++j) { const f32x2 w = *(const f32x2*)(args.conv_w + j * CCH + c0); w0[j] = w.x; w1[j] = w.y; }
            const f32x2 cb = *(const f32x2*)(args.conv_b + c0);
            unsigned uw[62];
#pragma unroll
            for (int i = 0; i < 62; ++i) { const int tr = tb0 - 30 + i; uw[i] = (tr >= 0) ? *(const unsigned*)(Ub + (size_t)tr * CCH + c0) : 0u; }
#pragma unroll
            for (int i = 0; i < 32; ++i) { float a0 = cb.x, a1 = cb.y;
#pragma unroll
                for (int j = 0; j < CONVW; ++j) { a0 += w0[j] * bf_lo(uw[i + j]); a1 += w1[j] * bf_hi(uw[i + j]); }
                *(LAS f32x2*)(cv + i * CCH + c0) = (f32x2){a0, a1}; }
            __syncthreads();
#pragma unroll 1
            for (int i = wave; i < 32; i += 8) {
                f32x4 v[4]; float s = 0.f;
#pragma unroll
                for (int k = 0; k < 4; ++k) { v[k] = *(const LAS f32x4*)(cv + i * CCH + 4 * lane + 256 * k); s += (v[k].x + v[k].y) + (v[k].z + v[k].w); }
                const float mean = wave_sum(s) * (1.f / CCH); float s2 = 0.f;
#pragma unroll
                for (int k = 0; k < 4; ++k) { v[k] = v[k] - mean; s2 += (v[k].x * v[k].x + v[k].y * v[k].y) + (v[k].z * v[k].z + v[k].w * v[k].w); }
                const float rstd = __builtin_amdgcn_rsqf(wave_sum(s2) * (1.f / CCH) + NORM_EPS);
                bf16* orow = MIX + (size_t)(tb0 + i) * DM;
#pragma unroll
                for (int k = 0; k < 4; ++k) { const int c = 4 * lane + 256 * k; const f32x4 gg = *(const f32x4*)(args.conv_ln_g + c), bb = *(const f32x4*)(args.conv_ln_b + c);
                    f32x4 y = v[k] * rstd * gg + bb; y.x *= sigmoidf_(y.x); y.y *= sigmoidf_(y.y); y.z *= sigmoidf_(y.z); y.w *= sigmoidf_(y.w);
                    v2u w; w.x = pk2(y.x, y.y); w.y = pk2(y.z, y.w); *(v2u*)(orow + c) = w; }
            }
            __syncthreads();
        }
        if (BOTH(2)) GRID_BAR();
    }

    if (IN(3)) {
        pg8::Gemm g{MIX, BTOUT, DM}; pg8::StaticOrder S; S.init(SEQ, DM, G, bx);
        pg8::EpiResF32 E{args.x, args.out, XN, args.norm2_g};
        pg8::gemm_phase<pg8::EpiResF32, pg8::StaticOrder, true, false>(lds, g, S, E, nullptr, TID());
        if (BOTH(3)) GRID_BAR();
    }

    if (IN(4)) {
        const int tid = TID(), lane = tid & 63, li = lane & 15, kg = lane >> 4;
        LAS float* part = (LAS float*)lds;
        LAS float* logit = (LAS float*)(lds + 49152);
        LAS float* ssp = (LAS float*)(lds + 49152 + 6144);
        LAS float* rsl = ssp + 256;
        LAS int* selE = (LAS int*)(rsl + 32); LAS float* selW = (LAS float*)(selE + 64);
        int* tokpos = (int*)(ws + WS_TOKPOS); float* rstd_g = (float*)(ws + WS_RSTD);
        const bf16* WRH = (const bf16*)(ws + WS_WRH); const bf16* WRL = (const bf16*)(ws + WS_WRL);
        constexpr int NTILE = SEQ / 32;
        for (int tile = bx; tile < NTILE; tile += G) {
            const int t0 = 32 * tile;
            {
                const float* xp = args.out + (size_t)(t0 + li) * DM + 256 * wave + 8 * kg;
                const bf16* hp = WRH + (size_t)li * DM + 256 * wave + 8 * kg; const bf16* lp = WRL + (size_t)li * DM + 256 * wave + 8 * kg;
                f32x4 acc[2][3]; float ss[2] = {0.f, 0.f};
#pragma unroll
                for (int x = 0; x < 2; ++x)
#pragma unroll
                    for (int nt = 0; nt < 3; ++nt) acc[x][nt] = (f32x4){0.f, 0.f, 0.f, 0.f};
#pragma unroll 1
                for (int hf = 0; hf < 2; ++hf) {
                    f32x4 xa[2][4][2]; bf16x8 bh[4][3], bl[4][3];
#pragma unroll
                    for (int s4 = 0; s4 < 4; ++s4) { const int ko = 32 * (4 * hf + s4);
#pragma unroll
                        for (int x = 0; x < 2; ++x) { xa[x][s4][0] = *(const f32x4*)(xp + (size_t)(16 * x) * DM + ko); xa[x][s4][1] = *(const f32x4*)(xp + (size_t)(16 * x) * DM + ko + 4); }
#pragma unroll
                        for (int nt = 0; nt < 3; ++nt) { bh[s4][nt] = *(const bf16x8*)(hp + (size_t)(16 * nt) * DM + ko); bl[s4][nt] = *(const bf16x8*)(lp + (size_t)(16 * nt) * DM + ko); } }
                    asm volatile("s_waitcnt vmcnt(0)" ::: "memory"); __builtin_amdgcn_sched_barrier(0);
#pragma unroll
                    for (int s4 = 0; s4 < 4; ++s4)
#pragma unroll
                        for (int x = 0; x < 2; ++x) { const f32x4 a = xa[x][s4][0], b = xa[x][s4][1];
                            ss[x] += (a.x * a.x + a.y * a.y) + (a.z * a.z + a.w * a.w) + (b.x * b.x + b.y * b.y) + (b.z * b.z + b.w * b.w); }
                    __builtin_amdgcn_sched_barrier(0);
#pragma unroll
                    for (int s4 = 0; s4 < 4; ++s4)
#pragma unroll
                        for (int x = 0; x < 2; ++x) { const f32x4 a = xa[x][s4][0], b = xa[x][s4][1];
                            v4u h; h.x = cvt_pk_s(a.x, a.y); h.y = cvt_pk_s(a.z, a.w); h.z = cvt_pk_s(b.x, b.y); h.w = cvt_pk_s(b.z, b.w);
                            v4u l; l.x = cvt_pk_s(a.x - bf_lo(h.x), a.y - bf_hi(h.x)); l.y = cvt_pk_s(a.z - bf_lo(h.y), a.w - bf_hi(h.y));
                            l.z = cvt_pk_s(b.x - bf_lo(h.z), b.y - bf_hi(h.z)); l.w = cvt_pk_s(b.z - bf_lo(h.w), b.w - bf_hi(h.w));
                            const bf16x8 xh = __builtin_bit_cast(bf16x8, h), xl = __builtin_bit_cast(bf16x8, l);
#pragma unroll
                            for (int nt = 0; nt < 3; ++nt) {
                                acc[x][nt] = __builtin_amdgcn_mfma_f32_16x16x32_bf16(xl, bl[s4][nt], acc[x][nt], 0, 0, 0);
                                acc[x][nt] = __builtin_amdgcn_mfma_f32_16x16x32_bf16(xl, bh[s4][nt], acc[x][nt], 0, 0, 0);
                                acc[x][nt] = __builtin_amdgcn_mfma_f32_16x16x32_bf16(xh, bl[s4][nt], acc[x][nt], 0, 0, 0);
                                acc[x][nt] = __builtin_amdgcn_mfma_f32_16x16x32_bf16(xh, bh[s4][nt], acc[x][nt], 0, 0, 0); } }
                }
#pragma unroll
                for (int x = 0; x < 2; ++x) {
#pragma unroll
                    for (int nt = 0; nt < 3; ++nt)
#pragma unroll
                        for (int e = 0; e < 4; ++e) part[(wave * 32 + 16 * x + 4 * kg + e) * 48 + 16 * nt + li] = acc[x][nt][e];
                    float s1 = ss[x]; s1 += __shfl_xor(s1, 16); s1 += __shfl_xor(s1, 32);
                    if (kg == 0) ssp[wave * 32 + 16 * x + li] = s1; }
            }
            __syncthreads();
            for (int idx = tid; idx < 32 * 48; idx += 512) { float a = 0.f;
#pragma unroll
                for (int w8 = 0; w8 < 8; ++w8) a += part[w8 * 1536 + idx];
                logit[idx] = a; }
            if (tid < 32) { float a = 0.f;
#pragma unroll
                for (int w8 = 0; w8 < 8; ++w8) a += ssp[w8 * 32 + tid];
                const float r = __builtin_amdgcn_rsqf(a * (1.f / DM) + NORM_EPS); rsl[tid] = r; rstd_g[t0 + tid] = r; }
            __syncthreads();
            if (tid < 32) {
                const float rstd = rsl[tid]; const LAS float* lg = logit + tid * 48;
                int gidx = 0; float gmax = lg[0] * rstd + args.b_rg[0]; float glv[4]; glv[0] = gmax;
#pragma unroll
                for (int k = 1; k < 4; ++k) { glv[k] = lg[k] * rstd + args.b_rg[k]; if (glv[k] > gmax) { gmax = glv[k]; gidx = k; } }
                float gden = 0.f;
#pragma unroll
                for (int k = 0; k < 4; ++k) gden += __expf(glv[k] - gmax);
                const float gwt = 1.f / gden;
                int i0 = 0, i1 = -1; float v0 = -3.0e38f, v1 = -3.0e38f;
                for (int k = 0; k < 8; ++k) { const float v = lg[4 + 8 * gidx + k] * rstd + args.b_re[gidx * EPG + k];
                    if (v > v0) { v1 = v0; i1 = i0; v0 = v; i0 = k; } else if (v > v1) { v1 = v; i1 = k; } }
                const float p0 = 1.f / (1.f + __expf(v1 - v0)), p1 = 1.f - p0;
                selE[2 * tid] = gidx * EPG + i0; selE[2 * tid + 1] = gidx * EPG + i1; selW[2 * tid] = gwt * p0; selW[2 * tid + 1] = gwt * p1;
            }
            __syncthreads();
            if (wave == 0 && lane < NEXP) {
                const int e = lane; int cnt = 0;
                for (int i = 0; i < 64; ++i) cnt += (selE[i] == e) ? 1 : 0;
                unsigned base = 0u;
                if (cnt) base = __hip_atomic_fetch_add((unsigned*)(ctl + CW_CNT + 64 * e), (unsigned)cnt, RLX_AGENT);
                for (int i = 0; i < 64; ++i) if (selE[i] == e) { const int t = t0 + (i >> 1); ltok[e * SEQ + base] = t; lw[e * SEQ + base] = selW[i]; tokpos[2 * t + (i & 1)] = (e << 16) | (int)base; ++base; }
            }
            __syncthreads();
        }
        if (BOTH(4)) GRID_BAR();
    }

    if (IN(5) || IN(6) || IN(7)) {
        LAS int* mtok = (LAS int*)(lds + MOE_TOK_OFF); LAS float* mw = (LAS float*)(lds + MOE_W_OFF); LAS float* mr = (LAS float*)(lds + MOE_R_OFF); LAS int* tb = (LAS int*)(lds + MOE_TB_OFF);
        pg8::MoeOrder S{tb, G, bx};
        { const int tid = TID();
        if (tid == 0) { int acc = 0; for (int e = 0; e < NEXP; ++e) { const int c = (int)__hip_atomic_load((unsigned*)(ctl + CW_CNT + 64 * e), RLX_AGENT); tb[e] = acc; tb[33 + e] = c; acc += (c + 255) >> 8; } tb[32] = acc;
            int ok = (G == 256) ? 1 : 0, F = 0, rank = 0, mine = 0; const int x = bx & 7, j = bx >> 3;
            for (int xx = 0; xx < 8; ++xx) { int tx = 0; for (int k = 0; k < 4; ++k) tx += tb[xx + 8 * k + 1] - tb[xx + 8 * k]; if (tx > 12) ok = 0;
                int f = 8 * tx - 64; f = f < 0 ? 0 : (f > 32 ? 32 : f);
                F += 32 - f; int below = j + (xx < x ? 1 : 0) - f; below = below < 0 ? 0 : (below > 32 - f ? 32 - f : below); rank += below; if (xx == x) mine = (j >= f) ? 1 : 0; }
            tb[66] = ok; tb[67] = F; tb[68] = mine ? rank : -1;
            for (int i = 0; i < MAXU; ++i) { int T = -1, e = 0, n = 0;
                if (ok) { const int U = i * 32 + j, LT = U >> 3; n = U & 7; int cum = 0;
                    for (int k = 0; k < 4; ++k) { const int ee = x + 8 * k, t0 = tb[ee], nt = tb[ee + 1] - t0; if (T < 0 && LT < cum + nt) { e = ee; T = t0 + (LT - cum); } cum += nt; } }
                else { const int L = i * G + bx; if (L < acc * 8) { T = L >> 3; n = L & 7; for (int k = 1; k < 32; ++k) e += (tb[k] <= T) ? 1 : 0; } }
                tb[80 + 4 * i] = T; tb[81 + 4 * i] = e; tb[82 + 4 * i] = n; tb[83 + 4 * i] = T < 0 ? 0 : T - tb[e]; } }
        __syncthreads();
        for (int i = 0; i < MAXU; ++i) { pg8::Unit u; if (!S.next(i, u)) break;
            if (tid < 256) { const int idx = 256 * u.lt + tid; const bool valid = idx < tb[33 + u.e];
                const int tk = valid ? ltok[u.e * SEQ + idx] : -1;
                mtok[i * 256 + tid] = tk; mw[i * 256 + tid] = valid ? lw[u.e * SEQ + idx] : 0.f; mr[i * 256 + tid] = valid ? ((const float*)(ws + WS_RSTD))[tk] : 0.f; } }
        }
        __syncthreads();
        if (IN(5)) {
            pg8::Gemm g{XN, BTGU, DM / 2};
            pg8::EpiSwiGLU E{Hb, mw, mr};
            pg8::gemm_phase<pg8::EpiSwiGLU, pg8::MoeOrder, true, true, true>(lds, g, S, E, mtok, TID());
            {
                const int units = tb[32] * 8, rem = units % G; int tailb = rem > 0 ? G - rem : G, ti = rem > 0 ? bx - rem : bx;
                if (tb[66]) { if (tb[67] > 0) { tailb = tb[67]; ti = tb[68]; } else { tailb = G; ti = bx; } }
                if (ti >= 0) { const int lane = lane_id_v(); const int q = (CV_N5 + tailb * 8 - 1) / (tailb * 8), x0 = (ti * 8 + wave) * q, x1 = (x0 + q < CV_N5) ? x0 + q : CV_N5;
                    convert_range(args.w_gate, args.w_up, args.w_down, BTGU, BTD, CV_GU + CV_D - CV_N5 + x0, CV_GU + CV_D - CV_N5 + x1, lds + wave * 8448, lane); }
            }
            if (BOTH(5)) GRID_BAR();
        }
        if (IN(6)) {
            pg8::Gemm g{Hb, BTD, DFF / 2};
            pg8::EpiYStore E{Yb};
            pg8::gemm_phase<pg8::EpiYStore, pg8::MoeOrder, true, false, true>(lds, g, S, E, nullptr, TID());
            if (BOTH(6)) GRID_BAR();
        }
        if (IN(7)) {
            const int lane = lane_id_v();
            const int* tokpos = (const int*)(ws + WS_TOKPOS);
            for (int t = gw; t < SEQ; t += NGW) {
                const int c0 = tokpos[2 * t], c1 = tokpos[2 * t + 1];
                const size_t r0 = (size_t)(256 * tb[c0 >> 16] + (c0 & 0xffff)), r1 = (size_t)(256 * tb[c1 >> 16] + (c1 & 0xffff));
                const GAS f32x4* xo = (const GAS f32x4*)(args.out + (size_t)t * DM) + lane; GAS f32x4* xw = (GAS f32x4*)(args.out_w + (size_t)t * DM) + lane;
                const GAS v2u* y0 = (const GAS v2u*)(Yb + r0 * DM) + lane; const GAS v2u* y1 = (const GAS v2u*)(Yb + r1 * DM) + lane;
#pragma unroll
                for (int j = 0; j < 8; ++j) { f32x4 a = __builtin_nontemporal_load(xo + 64 * j); const v2u b0 = __builtin_nontemporal_load(y0 + 64 * j), b1 = __builtin_nontemporal_load(y1 + 64 * j);
                    a.x = (a.x + bf_lo(b0.x)) + bf_lo(b1.x); a.y = (a.y + bf_hi(b0.x)) + bf_hi(b1.x); a.z = (a.z + bf_lo(b0.y)) + bf_lo(b1.y); a.w = (a.w + bf_hi(b0.y)) + bf_hi(b1.y);
                    __builtin_nontemporal_store(a, xw + 64 * j); }
            }
        }
    }
#undef IN
#undef BOTH
#undef GRID_BAR
#undef TID
}

extern "C" void kernel_launch(void* const* d_in, const int* in_sizes, int n_in, void* d_out, int out_size, void* d_ws, size_t ws_size, hipStream_t stream) {
    static int grid = 0;
    if (grid == 0) {
        if (n_in != 19 || out_size != SEQ * DM || ws_size < WS_END) { fprintf(stderr, "kernel_launch: unexpected sizes (n_in %d out %d ws %zu)\n", n_in, out_size, ws_size); grid = -1; return; }
        int dev = 0, cus = 0, per_cu = 0;
        if (hipGetDevice(&dev) != hipSuccess || hipDeviceGetAttribute(&cus, hipDeviceAttributeMultiprocessorCount, dev) != hipSuccess) { grid = -1; return; }
        if (hipFuncSetAttribute((const void*)hymba_fwd, hipFuncAttributeMaxDynamicSharedMemorySize, LDS_BYTES) != hipSuccess) { fprintf(stderr, "kernel_launch: hipFuncSetAttribute failed\n"); grid = -1; return; }
        if (hipOccupancyMaxActiveBlocksPerMultiprocessor(&per_cu, (const void*)hymba_fwd, 512, LDS_BYTES) != hipSuccess || per_cu < 1) fprintf(stderr, "kernel_launch: occupancy query reports %d\n", per_cu);
        (void)hipGetLastError();
        grid = cus;
    }
    if (grid < 0) return;
    if (hipMemsetAsync((char*)d_ws + WS_CTL, 0, CTL_ZERO_BYTES, stream) != hipSuccess) return;
    Args a{};
    a.x = (const float*)d_in[0]; a.norm1_g = (const float*)d_in[1]; a.w_in = (const float*)d_in[2]; a.q_norm_g = (const float*)d_in[3]; a.k_norm_g = (const float*)d_in[4];
    a.conv_w = (const float*)d_in[5]; a.conv_b = (const float*)d_in[6]; a.conv_ln_g = (const float*)d_in[7]; a.conv_ln_b = (const float*)d_in[8]; a.rel_bias = (const float*)d_in[9];
    a.w_out = (const float*)d_in[10]; a.norm2_g = (const float*)d_in[11]; a.w_rg = (const float*)d_in[12]; a.b_rg = (const float*)d_in[13]; a.w_re = (const float*)d_in[14]; a.b_re = (const float*)d_in[15];
    a.w_gate = (const float*)d_in[16]; a.w_up = (const float*)d_in[17]; a.w_down = (const float*)d_in[18];
    a.out = (float*)d_out; a.out_w = (float*)d_out; a.ws = (unsigned char*)d_ws;
    if (N_LAUNCHES == 1) { a.ph_lo = 0; a.ph_hi = N_PHASES; hipLaunchKernelGGL(hymba_fwd, dim3(grid), dim3(512), LDS_BYTES, stream, a); }
    else {
#ifndef MK_PROBE
#define MK_PROBE -1
#endif
        for (int p = 0; p < N_PHASES; ++p) { a.ph_lo = p; a.ph_hi = p + 1; hipLaunchKernelGGL(hymba_fwd, dim3(grid), dim3(512), LDS_BYTES, stream, a);
            if (p == MK_PROBE) { Args b = a;
                if (p == 7) b.out_w = (float*)((char*)d_ws + WS_Q);
                if (p == 4) { b.ws = (unsigned char*)d_ws + 700 * MiB; (void)hipMemsetAsync(b.ws, 0, CTL_ZERO_BYTES, stream); }
                hipLaunchKernelGGL(hymba_fwd, dim3(grid), dim3(512), LDS_BYTES, stream, b); } }
    }
}
```

```cpp
#include <hip/hip_runtime.h>
#include <cstdio>
#include <cstdint>

#ifndef MK_N_LAUNCHES
#define MK_N_LAUNCHES 1
#endif
constexpr int N_LAUNCHES = MK_N_LAUNCHES;
constexpr int N_PHASES = 8;

#define GAS __attribute__((address_space(1)))
#define LAS __attribute__((address_space(3)))
typedef unsigned short bf16;
typedef unsigned v4u __attribute__((ext_vector_type(4)));
typedef unsigned v2u __attribute__((ext_vector_type(2)));
typedef float f32x4 __attribute__((ext_vector_type(4)));
typedef float f32x2 __attribute__((ext_vector_type(2)));
typedef short bf16x8 __attribute__((ext_vector_type(8)));
typedef short s16x4 __attribute__((ext_vector_type(4)));
typedef GAS unsigned gu32;
typedef int v8i __attribute__((ext_vector_type(8)));
typedef int v4i __attribute__((ext_vector_type(4)));
#define RLX_AGENT __ATOMIC_RELAXED, __HIP_MEMORY_SCOPE_AGENT
#define LDS_WAIT() asm volatile("s_waitcnt lgkmcnt(0)" ::: "memory")
#define VM_WAIT() asm volatile("s_waitcnt vmcnt(0)" ::: "memory")

constexpr int SEQ = 8192, DM = 2048, CCH = 1024, AW = 1024, NH = 16, HD = 64, INW = 5120, CONVW = 31;
constexpr int NGRP = 4, EPG = 8, NEXP = 32, DFF = 1024;
constexpr float NORM_EPS = 1e-6f;
constexpr float LOG2E = 1.4426950408889634f;
constexpr float C2 = 0.125f * LOG2E;
constexpr int MAXT = 96;
constexpr int MAXU = 3;

constexpr size_t MiB = 1u << 20;
constexpr size_t WS_CTL = 0, CTL_ZERO_BYTES = 40960;
constexpr size_t WS_LTOK = 1 * MiB;
constexpr size_t WS_LW = 2 * MiB;
constexpr size_t WS_BTIN = 4 * MiB;
constexpr size_t WS_BTOUT = 24 * MiB;
constexpr size_t WS_XN = 32 * MiB;
constexpr size_t WS_U = 64 * MiB;
constexpr size_t WS_Q = 80 * MiB, WS_K = 96 * MiB, WS_V = 112 * MiB;
constexpr size_t WS_MIX = 128 * MiB;
constexpr size_t WS_H = 160 * MiB;
constexpr size_t WS_BTGU = 208 * MiB;
constexpr size_t WS_BTD = 464 * MiB;
constexpr size_t WS_Y = 592 * MiB;
constexpr size_t WS_END = 688 * MiB;
constexpr size_t WS_TOKPOS = 3 * MiB;
constexpr size_t WS_RSTD = 3 * MiB + 65536;
constexpr size_t WS_WRH = 3 * MiB + 131072;
constexpr size_t WS_WRL = WS_WRH + 48 * 2048 * 2;
constexpr int CW_BAR = 0;
constexpr int CW_CNT = 4096;
static_assert((CW_CNT + 64 * 32) * 4 <= (int)CTL_ZERO_BYTES && 3456 <= CW_CNT, "control words inside the zeroed region");

constexpr int RING_BYTES = 131072;
constexpr int MOE_TOK_OFF = RING_BYTES;
constexpr int MOE_W_OFF = MOE_TOK_OFF + MAXU * 1024;
constexpr int MOE_R_OFF = MOE_W_OFF + MAXU * 1024;
constexpr int MOE_TB_OFF = MOE_R_OFF + MAXU * 1024;
constexpr int MISC_OFF = MOE_TB_OFF + 512;
constexpr int LDS_BYTES = 147456;
static_assert(MISC_OFF + 64 <= LDS_BYTES, "LDS map");

__device__ __forceinline__ unsigned f2bf(float f) { unsigned u = __builtin_bit_cast(unsigned, f); return (u + 0x7fffu + ((u >> 16) & 1u)) >> 16; }
__device__ __forceinline__ unsigned pk2(float lo, float hi) { return f2bf(lo) | (f2bf(hi) << 16); }
__device__ __forceinline__ unsigned cvt_pk_bf16(float lo, float hi) { unsigned r; asm volatile("v_cvt_pk_bf16_f32 %0, %1, %2" : "=v"(r) : "v"(lo), "v"(hi)); return r; }
typedef __bf16 bf16x2_t __attribute__((ext_vector_type(2)));
__device__ __forceinline__ unsigned cvt_pk_s(float lo, float hi) { const f32x2 v = {lo, hi}; const bf16x2_t b = __builtin_convertvector(v, bf16x2_t); return __builtin_bit_cast(unsigned, b); }
__device__ __forceinline__ unsigned pk4_fp8(float a, float b, float c, float d) { int p = 0; p = __builtin_amdgcn_cvt_pk_fp8_f32(a, b, p, false); p = __builtin_amdgcn_cvt_pk_fp8_f32(c, d, p, true); return (unsigned)p; }
constexpr float W8_SCALE = 64.f, H8_SCALE = 16.f;
__device__ __forceinline__ float bf_lo(unsigned u) { return __builtin_bit_cast(float, u << 16); }
__device__ __forceinline__ float bf_hi(unsigned u) { return __builtin_bit_cast(float, u & 0xffff0000u); }
__device__ __forceinline__ float sigmoidf_(float x) { return __builtin_amdgcn_rcpf(1.f + __expf(-x)); }
__device__ __forceinline__ int lane_id_v() { int l; asm volatile("v_mbcnt_lo_u32_b32 %0, -1, 0\n\tv_mbcnt_hi_u32_b32 %0, -1, %0" : "=v"(l)); return l; }
__device__ __forceinline__ float wave_sum(float v) {
#pragma unroll
    for (int o = 1; o < 64; o <<= 1) v += __shfl_xor(v, o);
    return v;
}

__constant__ unsigned char kBucket[3][132] = {
 {0,1,2,3,4,5,6,7,8,9,10,11,12,13,14,15,16,16,16,16,16,16,17,17,17,17,17,17,17,17,18,18,18,18,18,18,18,18,18,18,19,19,19,19,19,19,19,19,19,19,19,19,19,19,20,20,20,20,20,20,20,20,20,20,20,20,20,20,20,20,20,20,20,21,21,21,21,21,21,21,21,21,21,21,21,21,21,21,21,21,21,21,21,21,21,21,21,21,21,22,22,22,22,22,22,22,22,22,22,22,22,22,22,22,22,22,22,22,22,22,22,22,22,22,22,22,22,22,22,0,0,0},
 {0,4,8,12,16,16,17,17,18,18,19,19,19,19,20,20,20,20,20,21,21,21,21,21,21,22,22,22,22,22,22,22,22,22,23,23,23,23,23,23,23,23,23,23,23,23,24,24,24,24,24,24,24,24,24,24,24,24,24,24,24,24,25,25,25,25,25,25,25,25,25,25,25,25,25,25,25,25,25,25,25,25,25,26,26,26,26,26,26,26,26,26,26,26,26,26,26,26,26,26,26,26,26,26,26,26,26,26,26,26,26,26,26,27,27,27,27,27,27,27,27,27,27,27,27,27,27,27,27,0,0,0},
 {0,16,18,19,20,21,21,22,22,23,23,23,24,24,24,24,25,25,25,25,25,26,26,26,26,26,26,26,26,27,27,27,27,27,27,27,27,27,27,28,28,28,28,28,28,28,28,28,28,28,28,28,29,29,29,29,29,29,29,29,29,29,29,29,29,29,29,29,29,29,30,30,30,30,30,30,30,30,30,30,30,30,30,30,30,30,30,30,30,30,30,30,30,30,30,31,31,31,31,31,31,31,31,31,31,31,31,31,31,31,31,31,31,31,31,31,31,31,31,31,31,31,31,31,31,31,31,31,31,0,0,0}};

namespace pg8 {
constexpr int BM = 256, BK = 64, HALF = 128, HTB = HALF * BK * 2, STAGE_BYTES = 8 * HTB, NXCD = 8, WGM = 8;
__host__ __device__ __forceinline__ int lds_byte(int r, int c) { const int st = (r >> 4) * 2 + (c >> 5), rr = r & 15, cc = c & 31, ob = rr * 64 + cc * 2; return st * 1024 + (ob ^ (((ob >> 9) & 1) << 5)); }
__host__ __device__ __forceinline__ void stage_rc(int b, int& R, int& C) { const int st = b / 1024, sb = b % 1024, swz = sb ^ (((sb >> 9) & 1) << 5); R = (st >> 1) * 16 + swz / 64; C = (st & 1) * 32 + (swz % 64) / 2; }
__host__ __device__ __forceinline__ int perm32(int rho) { const int n = rho >> 4, i = rho & 15; return 8 * (i >> 2) + 4 * n + (i & 3); }

struct Unit { int pm, pn, e, lt, slot; };
struct Gemm { const bf16* A; const bf16* Bt; int K; };

struct StaticOrder {
    int nM, nN, nwg, G, c;
    __host__ __device__ void init(int M, int N, int G_, int c_) { nM = M / BM; nN = N / BM; nwg = nM * nN; G = G_; c = c_; }
    __host__ __device__ bool next(int i, Unit& u) const {
        const long L = (long)i * G + c; if (L >= nwg) return false;
        int wgid = (int)L; { const int q = nwg / NXCD, r = nwg % NXCD, xcd = wgid % NXCD, off = wgid / NXCD; wgid = (xcd < r ? xcd * (q + 1) : r * (q + 1) + (xcd - r) * q) + off; }
        const int nig = WGM * nN, gid = wgid / nig, fm = gid * WGM, gsz = (nM - fm) < WGM ? (nM - fm) : WGM;
        u.pm = fm + ((wgid % nig) % gsz); u.pn = (wgid % nig) / gsz; u.e = 0; u.lt = 0; u.slot = i; return true;
    }
};
struct MoeOrder {
    const LAS int* tb; int G, c;
    __device__ __forceinline__ bool next(int i, Unit& u) const {
        if (i >= MAXU) return false;
        const int T = __builtin_amdgcn_readfirstlane(tb[80 + 4 * i]); if (T < 0) return false;
        const int e = __builtin_amdgcn_readfirstlane(tb[81 + 4 * i]), n = __builtin_amdgcn_readfirstlane(tb[82 + 4 * i]);
        u.pm = T; u.pn = e * 8 + n; u.e = e; u.lt = __builtin_amdgcn_readfirstlane(tb[83 + 4 * i]); u.slot = i; return true;
    }
};

template <class Epi, class Sched, bool ALIGN_EPI, bool GATHER, bool F8 = false>
__device__ __forceinline__ void gemm_phase(LAS unsigned char* lds, const Gemm g, const Sched& S, const Epi& E, const LAS int* gtok, const int tid) {
    const int wid = __builtin_amdgcn_readfirstlane(tid >> 6), lane = tid & 63, wr = wid >> 2, wc = wid & 3, fr = lane & 15, fq = lane >> 4;
    const int K = g.K, nt = K / BK;
    const size_t kstep = (size_t)(BK * 2);
    const size_t hstep = (size_t)HALF * K * 2;
    const size_t tstep = 2 * hstep;
    unsigned voffB[2], vA[2][2];
#pragma unroll
    for (int i = 0; i < 2; ++i) { int R, C; stage_rc(tid * 16 + i * 8192, R, C); const int Rb = Epi::PERM ? ((R & ~31) + perm32(R & 31)) : R;
        voffB[i] = (unsigned)(Rb * K + C) * 2u;
        vA[0][i] = (unsigned)(R * K + C) * 2u; vA[1][i] = vA[0][i] + (unsigned)hstep; }
    const unsigned ldsw = (unsigned)wid * 1024u;
    const int aoff = lds_byte(wr * 64 + fr, fq * 8), boff = lds_byte(wc * 32 + fr, fq * 8);
#define PG8_SA(b, h) (((b) * 2 + (h)) * HTB)
#define PG8_SB(b, h) ((4 + (b) * 2 + (h)) * HTB)
#define PG8_STAGE(bufoff, gbase, voff) do { const char* _gb = (const char*)(gbase); asm volatile("" : "+s"(_gb)); _Pragma("unroll") for (int _i = 0; _i < 2; ++_i) { unsigned _vo = (voff)[_i]; asm volatile("" : "+v"(_vo)); \
        __builtin_amdgcn_global_load_lds((const unsigned*)(_gb + _vo), (LAS unsigned*)(lds + (bufoff) + ldsw + _i * 8192), 16, 0, 0); } } while (0)
#define PG8_GLOAD(v, slot_) do { const int _t = wid * 64 + lane_id_v(); _Pragma("unroll") for (int _i = 0; _i < 2; ++_i) { int _R, _C; stage_rc(_t * 16 + _i * 8192, _R, _C); \
        _Pragma("unroll") for (int _h = 0; _h < 2; ++_h) { int _tk = gtok[(slot_) * 256 + 128 * _h + _R]; _tk = _tk < 0 ? 0 : _tk; v[_h][_i] = (unsigned)(_tk * K + _C) * 2u; } } } while (0)
#define PG8_LDA(dst, b, h) do { if constexpr (F8) { _Pragma("unroll") for (int m = 0; m < 4; ++m) { const v4i _lo = *(const LAS v4i*)(lds + PG8_SA(b, h) + aoff + m * 2048), _hi = *(const LAS v4i*)(lds + PG8_SA(b, h) + aoff + m * 2048 + 1024); \
            dst##8[m] = __builtin_shufflevector(_lo, _hi, 0, 1, 2, 3, 4, 5, 6, 7); } } \
        else { _Pragma("unroll") for (int m = 0; m < 4; ++m) _Pragma("unroll") for (int k = 0; k < 2; ++k) dst[m][k] = *(const LAS bf16x8*)(lds + PG8_SA(b, h) + aoff + m * 2048 + k * 1024); } } while (0)
#define PG8_LDB(dst, b, h) do { if constexpr (F8) { _Pragma("unroll") for (int n = 0; n < 2; ++n) { const v4i _lo = *(const LAS v4i*)(lds + PG8_SB(b, h) + boff + n * 2048), _hi = *(const LAS v4i*)(lds + PG8_SB(b, h) + boff + n * 2048 + 1024); \
            dst##8[n] = __builtin_shufflevector(_lo, _hi, 0, 1, 2, 3, 4, 5, 6, 7); } } \
        else { _Pragma("unroll") for (int n = 0; n < 2; ++n) _Pragma("unroll") for (int k = 0; k < 2; ++k) dst[n][k] = *(const LAS bf16x8*)(lds + PG8_SB(b, h) + boff + n * 2048 + k * 1024); } } while (0)
#define PG8_MMA(ai, bj, At, Bt) do { __builtin_amdgcn_s_setprio(1); \
        if constexpr (F8) { _Pragma("unroll") for (int m = 0; m < 4; ++m) _Pragma("unroll") for (int n = 0; n < 2; ++n) \
            acc[ai][bj][m][n] = __builtin_amdgcn_mfma_scale_f32_16x16x128_f8f6f4(Bt##8[n], At##8[m], acc[ai][bj][m][n], 0, 0, 0, 0x7f7f7f7f, 0, 0x7f7f7f7f); } \
        else { _Pragma("unroll") for (int m = 0; m < 4; ++m) _Pragma("unroll") for (int n = 0; n < 2; ++n) _Pragma("unroll") for (int k = 0; k < 2; ++k) \
            acc[ai][bj][m][n] = __builtin_amdgcn_mfma_f32_16x16x32_bf16(Bt[n][k], At[m][k], acc[ai][bj][m][n], 0, 0, 0); } \
        __builtin_amdgcn_s_setprio(0); } while (0)
#define PG8_WAIT_V(n) asm volatile("s_waitcnt vmcnt(" #n ")" ::: "memory")
#define PG8_WAIT_L(n) asm volatile("s_waitcnt lgkmcnt(" #n ")" ::: "memory")
#define PG8_BAR __builtin_amdgcn_s_barrier()
#define PG8_SCHED __builtin_amdgcn_sched_barrier(0)
    Unit cur, nxt; int ui = 0;
    if (!S.next(0, cur)) return;
    f32x4 acc[2][2][4][2];
#pragma unroll
    for (int a = 0; a < 2; ++a)
#pragma unroll
        for (int b = 0; b < 2; ++b)
#pragma unroll
            for (int m = 0; m < 4; ++m)
#pragma unroll
                for (int n = 0; n < 2; ++n) acc[a][b][m][n] = (f32x4){0.f, 0.f, 0.f, 0.f};
    bf16x8 At[4][2], B0[2][2], B1[2][2]; v8i At8[4], B08[2], B18[2];
    const char* cA = GATHER ? (const char*)g.A : (const char*)g.A + (size_t)cur.pm * tstep; const char* cB = (const char*)g.Bt + (size_t)cur.pn * tstep;
    if constexpr (GATHER) { PG8_GLOAD(vA, cur.slot); }
    PG8_STAGE(PG8_SB(0, 0), cB, voffB); PG8_STAGE(PG8_SB(0, 1), cB + hstep, voffB); PG8_STAGE(PG8_SA(0, 0), cA, vA[0]); PG8_STAGE(PG8_SA(0, 1), cA, vA[1]);
    if (wr == 1) PG8_BAR;
    PG8_WAIT_V(2); PG8_BAR;
    PG8_STAGE(PG8_SB(1, 0), cB + kstep, voffB); PG8_STAGE(PG8_SA(1, 0), cA + kstep, vA[0]); PG8_STAGE(PG8_SB(1, 1), cB + hstep + kstep, voffB);
    PG8_WAIT_V(6); PG8_BAR;
    for (;;) {
        const bool has_next = S.next(ui + 1, nxt);
        const char* nA = GATHER ? cA : (has_next ? (const char*)g.A + (size_t)nxt.pm * tstep : cA); const char* nB = has_next ? (const char*)g.Bt + (size_t)nxt.pn * tstep : cB;

#pragma unroll 1
        for (int t = 0; t < nt; t += 2) {
            const bool last = (t == nt - 2);
            const char* a1 = cA + (size_t)(t + 1) * kstep;
            const char* a2 = last ? nA : cA + (size_t)(t + 2) * kstep; const char* b2 = last ? nB : cB + (size_t)(t + 2) * kstep;
            const char* a3 = a2 + kstep; const char* b3 = b2 + kstep;
            unsigned vS[2][2];
#pragma unroll
            for (int h = 0; h < 2; ++h)
#pragma unroll
                for (int i = 0; i < 2; ++i) vS[h][i] = vA[h][i];
            if constexpr (GATHER) { if (last && has_next) { PG8_GLOAD(vS, nxt.slot); } }

            PG8_LDB(B0, 0, 0); PG8_LDB(B1, 0, 1); PG8_SCHED; PG8_LDA(At, 0, 0); PG8_STAGE(PG8_SA(1, 1), a1, vA[1]);
            PG8_WAIT_V(8); PG8_WAIT_L(0); PG8_BAR; PG8_MMA(0, 0, At, B0); PG8_MMA(0, 1, At, B1); PG8_BAR; PG8_SCHED;
            PG8_LDA(At, 0, 1); PG8_STAGE(PG8_SB(0, 0), b2, voffB); PG8_STAGE(PG8_SB(0, 1), b2 + hstep, voffB); PG8_STAGE(PG8_SA(0, 0), a2, vS[0]);
            PG8_WAIT_V(8); PG8_WAIT_L(0); PG8_BAR; PG8_MMA(1, 0, At, B0); PG8_MMA(1, 1, At, B1); PG8_BAR; PG8_SCHED;
            PG8_LDB(B0, 1, 0); PG8_LDB(B1, 1, 1); PG8_SCHED; PG8_LDA(At, 1, 0); PG8_STAGE(PG8_SA(0, 1), a2, vS[1]);
            PG8_WAIT_V(8); PG8_WAIT_L(0); PG8_BAR; PG8_MMA(0, 0, At, B0); PG8_MMA(0, 1, At, B1); PG8_BAR; PG8_SCHED;
            PG8_LDA(At, 1, 1); PG8_STAGE(PG8_SB(1, 0), b3, voffB); PG8_STAGE(PG8_SB(1, 1), b3 + hstep, voffB); PG8_STAGE(PG8_SA(1, 0), a3, vS[0]);
            PG8_WAIT_V(8); PG8_WAIT_L(0); PG8_BAR; PG8_MMA(1, 0, At, B0); PG8_MMA(1, 1, At, B1); PG8_BAR; PG8_SCHED;
        }
        if constexpr (ALIGN_EPI) { if (wr == 0) PG8_BAR; }
        { const int _l = lane_id_v();
          E(acc, cur, wr, wc, _l & 15, _l >> 4); }
        if (!has_next) break;
#pragma unroll
        for (int a = 0; a < 2; ++a)
#pragma unroll
            for (int b = 0; b < 2; ++b)
#pragma unroll
                for (int m = 0; m < 4; ++m)
#pragma unroll
                    for (int n = 0; n < 2; ++n) acc[a][b][m][n] = (f32x4){0.f, 0.f, 0.f, 0.f};
        cur = nxt; cA = nA; cB = nB; ++ui;
        if constexpr (GATHER) { PG8_GLOAD(vA, cur.slot); }
        if constexpr (ALIGN_EPI) { if (wr == 1) PG8_BAR; }
    }
    PG8_WAIT_V(0);
    if constexpr (!ALIGN_EPI) { if (wr == 0) PG8_BAR; }
    PG8_BAR;
#undef PG8_SA
#undef PG8_SB
#undef PG8_STAGE
#undef PG8_GLOAD
#undef PG8_LDA
#undef PG8_LDB
#undef PG8_MMA
#undef PG8_WAIT_V
#undef PG8_WAIT_L
#undef PG8_BAR
#undef PG8_SCHED
}

typedef const f32x4 (&AccRef)[2][2][4][2];
struct EpiInProj {
    static constexpr bool PERM = true;
    bf16 *U, *Q, *Kb, *V; const float *qg, *kg;
    __device__ __forceinline__ void operator()(AccRef acc, const Unit& u, int wr, int wc, int fr, int fq) const {
        const int row0 = u.pm * BM + wr * 64 + fr;
        if (u.pn < 8) {
#pragma unroll
            for (int ai = 0; ai < 2; ++ai)
#pragma unroll
                for (int m = 0; m < 4; ++m) { const int r = row0 + ai * HALF + m * 16;
                    f32x4 a0 = acc[ai][0][m][0], a1 = acc[ai][0][m][1], g0 = acc[ai][1][m][0], g1 = acc[ai][1][m][1];
                    v4u w; w.x = cvt_pk_bf16(a0[0] * sigmoidf_(g0[0]), a0[1] * sigmoidf_(g0[1])); w.y = cvt_pk_bf16(a0[2] * sigmoidf_(g0[2]), a0[3] * sigmoidf_(g0[3]));
                    w.z = cvt_pk_bf16(a1[0] * sigmoidf_(g1[0]), a1[1] * sigmoidf_(g1[1])); w.w = cvt_pk_bf16(a1[2] * sigmoidf_(g1[2]), a1[3] * sigmoidf_(g1[3]));
                    *(v4u*)(U + (size_t)r * CCH + 128 * u.pn + 32 * wc + 8 * fq) = w; }
        } else if (u.pn < 16) {
            const int t = u.pn - 8, tensor = t >> 2, head = 4 * (t & 3) + wc;
            const float* gn = tensor ? kg : qg; bf16* dst = tensor ? Kb : Q; const float sc0 = tensor ? 1.f : C2;
            f32x4 gv[2][2];
#pragma unroll
            for (int bj = 0; bj < 2; ++bj)
#pragma unroll
                for (int n = 0; n < 2; ++n) gv[bj][n] = *(const f32x4*)(gn + 32 * bj + 8 * fq + 4 * n);
#pragma unroll
            for (int ai = 0; ai < 2; ++ai)
#pragma unroll
                for (int m = 0; m < 4; ++m) { const int r = row0 + ai * HALF + m * 16; float ss = 0.f;
#pragma unroll
                    for (int bj = 0; bj < 2; ++bj)
#pragma unroll
                        for (int n = 0; n < 2; ++n) { const f32x4 v = acc[ai][bj][m][n]; ss += (v[0] * v[0] + v[1] * v[1]) + (v[2] * v[2] + v[3] * v[3]); }
                    ss += __shfl_xor(ss, 16); ss += __shfl_xor(ss, 32);
                    const float sc = sc0 * __builtin_amdgcn_rsqf(ss * (1.f / 64.f) + NORM_EPS);
#pragma unroll
                    for (int bj = 0; bj < 2; ++bj) { const f32x4 v0 = acc[ai][bj][m][0] * gv[bj][0] * sc, v1 = acc[ai][bj][m][1] * gv[bj][1] * sc;
                        v4u w; w.x = cvt_pk_bf16(v0[0], v0[1]); w.y = cvt_pk_bf16(v0[2], v0[3]); w.z = cvt_pk_bf16(v1[0], v1[1]); w.w = cvt_pk_bf16(v1[2], v1[3]);
                        *(v4u*)(dst + (size_t)r * AW + 64 * head + 32 * bj + 8 * fq) = w; } }
        } else {
            const int cb = 256 * (u.pn - 16) + 32 * wc + 8 * fq;
#pragma unroll
            for (int ai = 0; ai < 2; ++ai)
#pragma unroll
                for (int m = 0; m < 4; ++m) { const int r = row0 + ai * HALF + m * 16;
#pragma unroll
                    for (int bj = 0; bj < 2; ++bj) { const f32x4 v0 = acc[ai][bj][m][0], v1 = acc[ai][bj][m][1];
                        v4u w; w.x = cvt_pk_bf16(v0[0], v0[1]); w.y = cvt_pk_bf16(v0[2], v0[3]); w.z = cvt_pk_bf16(v1[0], v1[1]); w.w = cvt_pk_bf16(v1[2], v1[3]);
                        *(v4u*)(V + (size_t)r * AW + cb + 128 * bj) = w; } }
        }
    }
};
struct EpiResF32 {
    static constexpr bool PERM = true;
    const float* X; float* O; bf16* HN; const float* g2;
    __device__ __forceinline__ void operator()(AccRef acc, const Unit& u, int wr, int wc, int fr, int fq) const {
        const int row0 = u.pm * BM + wr * 64 + fr, col0 = u.pn * BM + wc * 32 + 8 * fq;
        f32x4 gv[2][2];
#pragma unroll
        for (int bj = 0; bj < 2; ++bj)
#pragma unroll
            for (int n = 0; n < 2; ++n) gv[bj][n] = *(const f32x4*)(g2 + col0 + bj * HALF + 4 * n);
#pragma unroll
        for (int ai = 0; ai < 2; ++ai)
#pragma unroll
            for (int m = 0; m < 4; ++m) { const size_t ro = (size_t)(row0 + ai * HALF + m * 16) * DM + col0;
                f32x4 xv[2][2];
#pragma unroll
                for (int bj = 0; bj < 2; ++bj)
#pragma unroll
                    for (int n = 0; n < 2; ++n) xv[bj][n] = __builtin_nontemporal_load((const f32x4*)(X + ro + bj * HALF + 4 * n));
#pragma unroll
                for (int bj = 0; bj < 2; ++bj) { const f32x4 a = xv[bj][0] + acc[ai][bj][m][0], b = xv[bj][1] + acc[ai][bj][m][1];
                    *(f32x4*)(O + ro + bj * HALF) = a; *(f32x4*)(O + ro + bj * HALF + 4) = b;
                    const f32x4 ha = a * gv[bj][0], hb = b * gv[bj][1];
                    v2u w; w.x = pk4_fp8(ha[0], ha[1], ha[2], ha[3]); w.y = pk4_fp8(hb[0], hb[1], hb[2], hb[3]);
                    *(v2u*)((unsigned char*)HN + ro + bj * HALF) = w; } }
    }
};
struct EpiSwiGLU {
    static constexpr bool PERM = true;
    bf16* H; const LAS float* wts; const LAS float* rs;
    __device__ __forceinline__ void operator()(AccRef acc, const Unit& u, int wr, int wc, int fr, int fq) const {
        const int cb = 128 * (u.pn & 7) + 32 * wc + 8 * fq;
#pragma unroll
        for (int ai = 0; ai < 2; ++ai)
#pragma unroll
            for (int m = 0; m < 4; ++m) { const int R = ai * HALF + wr * 64 + m * 16 + fr; const float r = rs[u.slot * 256 + R] * (1.f / W8_SCALE), w = wts[u.slot * 256 + R] * r * H8_SCALE;
                const f32x4 g0 = acc[ai][0][m][0] * r, g1 = acc[ai][0][m][1] * r, u0 = acc[ai][1][m][0] * w, u1 = acc[ai][1][m][1] * w;
                v2u o; o.x = pk4_fp8(g0[0] * sigmoidf_(g0[0]) * u0[0], g0[1] * sigmoidf_(g0[1]) * u0[1], g0[2] * sigmoidf_(g0[2]) * u0[2], g0[3] * sigmoidf_(g0[3]) * u0[3]);
                o.y = pk4_fp8(g1[0] * sigmoidf_(g1[0]) * u1[0], g1[1] * sigmoidf_(g1[1]) * u1[1], g1[2] * sigmoidf_(g1[2]) * u1[2], g1[3] * sigmoidf_(g1[3]) * u1[3]);
                *(v2u*)((unsigned char*)H + (size_t)(u.pm * BM + R) * DFF + cb) = o; }
    }
};
struct EpiYStore {
    static constexpr bool PERM = true;
    bf16* Y;
    __device__ __forceinline__ void operator()(AccRef acc, const Unit& u, int wr, int wc, int fr, int fq) const {
        const int cb = 256 * (u.pn & 7) + 32 * wc + 8 * fq;
#pragma unroll
        for (int ai = 0; ai < 2; ++ai)
#pragma unroll
            for (int m = 0; m < 4; ++m) { const int R = ai * HALF + wr * 64 + m * 16 + fr;
#pragma unroll
                for (int bj = 0; bj < 2; ++bj) { const f32x4 v0 = acc[ai][bj][m][0] * (1.f / (W8_SCALE * H8_SCALE)), v1 = acc[ai][bj][m][1] * (1.f / (W8_SCALE * H8_SCALE));
                    v4u w; w.x = cvt_pk_bf16(v0[0], v0[1]); w.y = cvt_pk_bf16(v0[2], v0[3]); w.z = cvt_pk_bf16(v1[0], v1[1]); w.w = cvt_pk_bf16(v1[2], v1[3]);
                    *(v4u*)(Y + (size_t)(u.pm * BM + R) * DM + cb + 128 * bj) = w; } }
    }
};
struct EpiScatter {
    static constexpr bool PERM = false;
    float* O; const LAS int* toks;
    __device__ __forceinline__ void operator()(AccRef acc, const Unit& u, int wr, int wc, int fr, int fq) const {
        const int col0 = (u.pn & 7) * BM + wc * 32 + 4 * fq;
#pragma unroll
        for (int ai = 0; ai < 2; ++ai)
#pragma unroll
            for (int m = 0; m < 4; ++m) { const int R = ai * HALF + wr * 64 + m * 16 + fr; const int tok = toks[u.slot * 256 + R];
                if (tok >= 0) { float* ro = O + (size_t)tok * DM + col0;
#pragma unroll
                    for (int bj = 0; bj < 2; ++bj)
#pragma unroll
                        for (int n = 0; n < 2; ++n) { const f32x4 v = acc[ai][bj][m][n]; float* p = ro + bj * HALF + n * 16;
                            unsafeAtomicAdd(p + 0, v[0]); unsafeAtomicAdd(p + 1, v[1]); unsafeAtomicAdd(p + 2, v[2]); unsafeAtomicAdd(p + 3, v[3]); } } }
    }
};
}

#define XB_TMO      128
#define XB_XCNT(j)  (256  + 64 * (j))
#define XB_XSUB(j)  (1280 + 64 * (j))
#define XB_XGEN(j)  (2304 + 64 * (j))
#define XB_TOP      3328
#define XB_TOPGEN   3392
#define XCD_BAR_WORDS 3456
#define XB_SPIN_CAP (1u << 18)
__device__ __forceinline__ unsigned xb_ld(unsigned* p)              { return __hip_atomic_load(p, __ATOMIC_RELAXED, __HIP_MEMORY_SCOPE_AGENT); }
__device__ __forceinline__ unsigned xb_add(unsigned* p, unsigned v) { return __hip_atomic_fetch_add(p, v, __ATOMIC_RELAXED, __HIP_MEMORY_SCOPE_AGENT); }
__device__ __forceinline__ unsigned xb_xcc_id() { return (unsigned)__builtin_amdgcn_s_getreg((3 << 11) | 20) & 0xFu; }
#define XB_SPIN(cond, bar) do { unsigned _sp = 0; while (cond) { __builtin_amdgcn_s_sleep(1); \
    if ((++_sp & 255u) == 0u) { if (xb_ld(&(bar)[XB_TMO])) break; if (_sp > XB_SPIN_CAP) { atomicAdd(&(bar)[XB_TMO], 1u); break; } } } } while (0)
struct XcdBarrier { unsigned* bar; unsigned x; volatile LAS unsigned* st; };
__device__ __forceinline__ XcdBarrier xcd_barrier_post(unsigned* bar, volatile LAS unsigned* st, const int tid) {
    XcdBarrier b; b.bar = bar; b.x = xb_xcc_id(); b.st = st;
    if (tid == 0) (void)xb_add(&bar[XB_XCNT(b.x)], 1u);
    return b;
}
__device__ __forceinline__ void xcd_barrier_complete(unsigned* bar, unsigned x, unsigned& nloc, unsigned& nx) {
    const unsigned G = gridDim.x * gridDim.y * gridDim.z;
    unsigned sum, cnt, mine, sp = 0u;
    for (;;) {
        sum = 0u; cnt = 0u; mine = 0u;
#pragma unroll
        for (unsigned j = 0; j < 16; ++j) { const unsigned c = xb_ld(&bar[XB_XCNT(j)]); sum += c; cnt += (c > 0u) ? 1u : 0u; mine = (j == x) ? c : mine; }
        if (sum == G) break;
        __builtin_amdgcn_s_sleep(1);
        if ((++sp & 255u) == 0u) { if (xb_ld(&bar[XB_TMO])) break; if (sp > XB_SPIN_CAP) { atomicAdd(&bar[XB_TMO], 1u); break; } }
    }
    nloc = mine > 0u ? mine : 1u; nx = cnt > 0u ? cnt : 1u;
}
__device__ __forceinline__ void xcd_barrier(const XcdBarrier& b, const int tid) {
    asm volatile("s_waitcnt vmcnt(0)" ::: "memory");
    __syncthreads();
    if (tid == 0) {
        unsigned* bar = b.bar;
        __builtin_amdgcn_s_waitcnt(0);
        unsigned nloc = b.st[0], nx = b.st[1];
        if (nloc == 0u) { xcd_barrier_complete(bar, b.x, nloc, nx); b.st[0] = nloc; b.st[1] = nx; }
        const unsigned old = xb_add(&bar[XB_XSUB(b.x)], 1u);
        const unsigned gen = old / nloc;
        if (old + 1u == (gen + 1u) * nloc) {
            __builtin_amdgcn_fence(__ATOMIC_RELEASE, "agent");
            asm volatile("s_waitcnt vmcnt(0)" ::: "memory");
            const unsigned og = xb_add(&bar[XB_TOP], 1u);
            const unsigned tg = og / nx;
            if (og + 1u == (tg + 1u) * nx) xb_add(&bar[XB_TOPGEN], 1u);
            else XB_SPIN(xb_ld(&bar[XB_TOPGEN]) == tg, bar);
            __builtin_amdgcn_fence(__ATOMIC_ACQUIRE, "agent");
            xb_add(&bar[XB_XGEN(b.x)], 1u);
            asm volatile("s_waitcnt vmcnt(0)" ::: "memory");
        } else {
            XB_SPIN(xb_ld(&bar[XB_XGEN(b.x)]) == gen, bar);
            __builtin_amdgcn_fence(__ATOMIC_ACQUIRE, "agent");
            asm volatile("s_waitcnt vmcnt(0)" ::: "memory");
        }
    }
    __syncthreads();
}

struct Args {
    const float *x, *norm1_g, *w_in, *q_norm_g, *k_norm_g, *conv_w, *conv_b, *conv_ln_g, *conv_ln_b, *rel_bias, *w_out, *norm2_g, *w_rg, *b_rg, *w_re, *b_re, *w_gate, *w_up, *w_down;
    float* out; float* out_w; unsigned char* ws; int ph_lo, ph_hi;
};

__device__ __forceinline__ void transpose_item(const float* Wsrc, int ldw, bf16* dst, int ldd, LAS float* scr, int lane) {
    const float* p = Wsrc + (size_t)(lane >> 5) * ldw + (lane & 31);
#pragma unroll 1
    for (int hh = 0; hh < 2; ++hh) {
        float tv[16];
#pragma unroll
        for (int i = 0; i < 16; ++i) { tv[i] = *p; p += 2 * ldw; }
#pragma unroll
        for (int i = 0; i < 16; ++i) { const int kk = 2 * (16 * hh + i) + (lane >> 5); scr[kk * 33 + (lane & 31)] = tv[i]; }
    }
    LDS_WAIT(); asm volatile("" ::: "memory");
    const int c = lane & 7;
#pragma unroll
    for (int j = 0; j < 4; ++j) { const int n = (lane >> 3) + 8 * j; const LAS float* s = scr + (8 * c) * 33 + n;
        v4u o; o.x = pk2(s[0 * 33], s[1 * 33]); o.y = pk2(s[2 * 33], s[3 * 33]); o.z = pk2(s[4 * 33], s[5 * 33]); o.w = pk2(s[6 * 33], s[7 * 33]);
        *(GAS v4u*)(dst + (size_t)n * ldd + 8 * c) = o; }
    LDS_WAIT(); asm volatile("" ::: "memory");
}
__device__ __forceinline__ void t64_load(const float* Wsrc, int ldw, int lane, f32x4 (&tv)[16]) {
    const float* p = Wsrc + (size_t)(lane >> 3) * ldw + 4 * (lane & 7);
#pragma unroll
    for (int i = 0; i < 16; ++i) { tv[i] = __builtin_nontemporal_load((const f32x4*)p); p += 8 * ldw; }
}
__device__ __forceinline__ void t64_finish(const f32x4 (&tv)[16], unsigned char* dst, int ldd, int f8, LAS unsigned char* scr, int lane) {
    const int g = lane >> 4, i16 = lane & 15;
#pragma unroll
    for (int i = 0; i < 16; ++i) { v2u w; w.x = cvt_pk_bf16(tv[i].x, tv[i].y); w.y = cvt_pk_bf16(tv[i].z, tv[i].w); *(LAS v2u*)(scr + (8 * i + (lane >> 3)) * 64 + 8 * (lane & 7)) = w; }
    LDS_WAIT(); asm volatile("" ::: "memory");
    const int q = i16 >> 2, pp = i16 & 3;
    bf16x8 o[8];
#pragma unroll
    for (int jj = 0; jj < 8; ++jj) { const int c = 4 * jj + g, nb = c & 1, kg = c >> 1;
        LAS unsigned char* ra = scr + (8 * kg + q) * 64 + 32 * nb + 8 * pp;
        const s16x4 lo = __builtin_bit_cast(s16x4, __builtin_amdgcn_ds_read_tr16_b64_v4i16((LAS s16x4*)ra));
        const s16x4 hi = __builtin_bit_cast(s16x4, __builtin_amdgcn_ds_read_tr16_b64_v4i16((LAS s16x4*)(ra + 4 * 64)));
        o[jj] = __builtin_shufflevector(lo, hi, 0, 1, 2, 3, 4, 5, 6, 7); }
    LDS_WAIT(); asm volatile("" ::: "memory");
#pragma unroll
    for (int jj = 0; jj < 8; ++jj) { const int c = 4 * jj + g, nb = c & 1, kg = c >> 1; const int n = 16 * nb + i16;
        *(LAS bf16x8*)(scr + n * 256 + 16 * (kg ^ (n & 15))) = o[jj]; }
    LDS_WAIT(); asm volatile("" ::: "memory");
    const int rr = lane >> 3, cc = lane & 7;
#pragma unroll
    for (int it = 0; it < 4; ++it) { const int n = 8 * it + rr;
        const v4u v0 = *(const LAS v4u*)(scr + n * 256 + 16 * ((2 * cc) ^ (n & 15))), v1 = *(const LAS v4u*)(scr + n * 256 + 16 * ((2 * cc + 1) ^ (n & 15)));
        if (f8) { v4u o4; o4.x = pk4_fp8(bf_lo(v0.x) * W8_SCALE, bf_hi(v0.x) * W8_SCALE, bf_lo(v0.y) * W8_SCALE, bf_hi(v0.y) * W8_SCALE);
            o4.y = pk4_fp8(bf_lo(v0.z) * W8_SCALE, bf_hi(v0.z) * W8_SCALE, bf_lo(v0.w) * W8_SCALE, bf_hi(v0.w) * W8_SCALE);
            o4.z = pk4_fp8(bf_lo(v1.x) * W8_SCALE, bf_hi(v1.x) * W8_SCALE, bf_lo(v1.y) * W8_SCALE, bf_hi(v1.y) * W8_SCALE);
            o4.w = pk4_fp8(bf_lo(v1.z) * W8_SCALE, bf_hi(v1.z) * W8_SCALE, bf_lo(v1.w) * W8_SCALE, bf_hi(v1.w) * W8_SCALE);
            __builtin_nontemporal_store(o4, (GAS v4u*)(dst + (size_t)n * ldd + 16 * cc)); }
        else { *(GAS v4u*)(dst + (size_t)n * ldd + 32 * cc) = v0; *(GAS v4u*)(dst + (size_t)n * ldd + 32 * cc + 16) = v1; } }
    LDS_WAIT(); asm volatile("" ::: "memory");
}
__device__ __forceinline__ int win_src_col(int n0) {
    const int pn = n0 >> 8, j = n0 & 255;
    if (pn < 8) return ((j >> 7) ? CCH : 0) + 128 * pn + (j & 127);
    if (pn < 16) { const int t = pn - 8, tensor = t >> 2, head = 4 * (t & 3) + ((j >> 5) & 3), dim = 32 * (j >> 7); return 2 * CCH + AW * tensor + 64 * head + dim; }
    return 2 * CCH + 2 * AW + 256 * (pn - 16) + j;
}
__device__ __forceinline__ void rms_row_to_bf16(const float* xrow, const float* g, bf16* orow, int lane) {
    const GAS f32x4* xr = (const GAS f32x4*)xrow + lane; const GAS f32x4* gr = (const GAS f32x4*)g + lane;
    f32x4 v[8]; float s = 0.f;
#pragma unroll
    for (int j = 0; j < 8; ++j) { v[j] = xr[64 * j]; s += (v[j].x * v[j].x + v[j].y * v[j].y) + (v[j].z * v[j].z + v[j].w * v[j].w); }
    const float rstd = __builtin_amdgcn_rsqf(wave_sum(s) * (1.f / DM) + NORM_EPS);
    GAS v2u* o8 = (GAS v2u*)orow + lane;
#pragma unroll
    for (int j = 0; j < 8; ++j) { const f32x4 gg = gr[64 * j]; v2u w; w.x = pk2(v[j].x * rstd * gg.x, v[j].y * rstd * gg.y); w.y = pk2(v[j].z * rstd * gg.z, v[j].w * rstd * gg.w); o8[64 * j] = w; }
}

template <int P, int NT>
__device__ __forceinline__ void attn_pattern(const bf16* __restrict__ Kh, const bf16* __restrict__ Vh, const int t0, LAS unsigned char* vbuf, const LAS float* bt,
                                             const bf16x8 (&qf)[NT][2], f32x4 (&o)[NT][4], f32x4 (&lacc)[NT], int lane) {
    constexpr int DL = (P == 0) ? 1 : (P == 1) ? 4 : 16, SQ = 16 / DL, GS = 3, NGRPS = (P == 0) ? 4 : 2;
    constexpr int SH = 8 / DL;
    static_assert(NT == 1 || P < 2, "tile pairs share keys only for dilation 1 and 4");
    const int qi = lane & 15, g = lane >> 4, q4 = qi >> 2, pp = qi & 3;
    const int xr = (2 * g + (q4 >> 1)) & 3;
    unsigned tra[4];
#pragma unroll
    for (int dt = 0; dt < 4; ++dt) tra[dt] = (unsigned)((4 * g + q4) * 128 + 32 * (dt ^ xr) + 8 * pp);
    unsigned klo[2], vlo[4], vwa[4];
#pragma unroll
    for (int tt = 0; tt < 2; ++tt) klo[tt] = (unsigned)(DL * (16 * tt + qi) * AW + 8 * g);
#pragma unroll
    for (int k = 0; k < 4; ++k) { const int idx = lane + 64 * k, row = idx >> 3, c16 = idx & 7; vlo[k] = (unsigned)(DL * row * AW + 8 * c16); vwa[k] = (unsigned)(row * 128 + 16 * (c16 ^ (((row >> 1) & 3) << 1))); }
    const int tq = t0 / DL;
    unsigned relmax[NT];
#pragma unroll
    for (int x = 0; x < NT; ++x) { const int m = SQ * qi + tq + x * SH; relmax[x] = (unsigned)(m < 128 ? m : 128); }
    const int relb = 128 + SQ * qi - 4 * g;
    const bf16x8 ones = (bf16x8){0x3f80, 0x3f80, 0x3f80, 0x3f80, 0x3f80, 0x3f80, 0x3f80, 0x3f80};
#pragma unroll 1
    for (int grp = 0; grp < NGRPS; ++grp) {
        bf16x8 kfg[GS][2][2]; v4u vrg[GS][4];
#pragma unroll
        for (int s3 = 0; s3 < GS; ++s3) { if (P == 2 && GS * grp + s3 >= 5) break;
            const long ro = ((long)t0 + DL * (32 * (GS * grp + s3) - 128)) * AW; const bf16* kb = Kh + ro; const bf16* vbs = Vh + ro;
#pragma unroll
            for (int tt = 0; tt < 2; ++tt) { kfg[s3][tt][0] = *(const bf16x8*)(kb + klo[tt]); kfg[s3][tt][1] = *(const bf16x8*)(kb + klo[tt] + 32); }
#pragma unroll
            for (int k = 0; k < 4; ++k) vrg[s3][k] = *(const v4u*)(vbs + vlo[k]); }
#pragma unroll
        for (int s3 = 0; s3 < GS; ++s3) {
            const int c = GS * grp + s3;
            if (P == 2 && c >= 5) break;
            LAS unsigned char* vb = vbuf + s3 * 4096;
#pragma unroll
            for (int k = 0; k < 4; ++k) *(LAS v4u*)(vb + vwa[k]) = vrg[s3][k];
            const int rel0 = relb - 32 * c;
            bf16x8 pf[NT];
#pragma unroll
            for (int x = 0; x < NT; ++x) {
                f32x4 sc[2];
#pragma unroll
                for (int tt = 0; tt < 2; ++tt) { f32x4 z = (f32x4){0.f, 0.f, 0.f, 0.f};
                    z = __builtin_amdgcn_mfma_f32_16x16x32_bf16(kfg[s3][tt][0], qf[x][0], z, 0, 0, 0);
                    sc[tt] = __builtin_amdgcn_mfma_f32_16x16x32_bf16(kfg[s3][tt][1], qf[x][1], z, 0, 0, 0); }
                const LAS float* btp = bt + (rel0 + x * SH - 19);
                float p[2][4];
#pragma unroll
                for (int tt = 0; tt < 2; ++tt)
#pragma unroll
                    for (int e = 0; e < 4; ++e) { const int rel = rel0 + x * SH - 16 * tt - e;
                        const float pe = __builtin_amdgcn_exp2f(sc[tt][e] + btp[19 - 16 * tt - e]);
                        p[tt][e] = ((unsigned)rel <= relmax[x]) ? pe : 0.f; }
                v4u pw; pw.x = cvt_pk_s(p[0][0], p[0][1]); pw.y = cvt_pk_s(p[0][2], p[0][3]); pw.z = cvt_pk_s(p[1][0], p[1][1]); pw.w = cvt_pk_s(p[1][2], p[1][3]);
                pf[x] = __builtin_bit_cast(bf16x8, pw);
                lacc[x] = __builtin_amdgcn_mfma_f32_16x16x32_bf16(ones, pf[x], lacc[x], 0, 0, 0);
            }
#pragma unroll
            for (int dt = 0; dt < 4; ++dt) {
                const s16x4 lo = __builtin_bit_cast(s16x4, __builtin_amdgcn_ds_read_tr16_b64_v4i16((LAS s16x4*)(vb + tra[dt])));
                const s16x4 hi = __builtin_bit_cast(s16x4, __builtin_amdgcn_ds_read_tr16_b64_v4i16((LAS s16x4*)(vb + tra[dt] + 2048)));
                const bf16x8 vf = __builtin_shufflevector(lo, hi, 0, 1, 2, 3, 4, 5, 6, 7);
#pragma unroll
                for (int x = 0; x < NT; ++x) o[x][dt] = __builtin_amdgcn_mfma_f32_16x16x32_bf16(vf, pf[x], o[x][dt], 0, 0, 0);
            }
        }
    }
}

__device__ __forceinline__ void attn_wave(const bf16* Q, const bf16* Kb, const bf16* Vb, bf16* MIX, int h, const int t0, LAS unsigned char* vbuf, const LAS float* bt, int lane) {
    asm volatile("" : "+v"(lane));
    const int qi = lane & 15, g = lane >> 4;
    bf16x8 qf[2][2]; f32x4 o[2][4]; f32x4 lacc[2];
#pragma unroll
    for (int x = 0; x < 2; ++x) { const bf16* qrow = Q + (size_t)(t0 + 8 * x + 16 * qi) * AW + 64 * h + 8 * g; qf[x][0] = *(const bf16x8*)qrow; qf[x][1] = *(const bf16x8*)(qrow + 32);
        lacc[x] = (f32x4){0.f, 0.f, 0.f, 0.f};
#pragma unroll
        for (int dt = 0; dt < 4; ++dt) o[x][dt] = (f32x4){0.f, 0.f, 0.f, 0.f}; }
    const bf16* Kh = Kb + 64 * h; const bf16* Vh = Vb + 64 * h;
    attn_pattern<0, 2>(Kh, Vh, t0, vbuf, bt, qf, o, lacc, lane);
    attn_pattern<1, 2>(Kh, Vh, t0, vbuf, bt + 132, qf, o, lacc, lane);
#pragma unroll
    for (int x = 0; x < 2; ++x) {
        bf16x8 q1[1][2] = {{qf[x][0], qf[x][1]}}; f32x4 o1[1][4] = {{o[x][0], o[x][1], o[x][2], o[x][3]}}; f32x4 l1[1] = {lacc[x]};
        attn_pattern<2, 1>(Kh, Vh, t0 + 8 * x, vbuf, bt + 264, q1, o1, l1, lane);
        const float inv = 1.f / l1[0][0];
        bf16* orow = MIX + (size_t)(t0 + 8 * x + 16 * qi) * DM + CCH + 64 * h + 4 * g;
#pragma unroll
        for (int dt = 0; dt < 4; ++dt) { v2u w; w.x = cvt_pk_bf16(o1[0][dt][0] * inv, o1[0][dt][1] * inv); w.y = cvt_pk_bf16(o1[0][dt][2] * inv, o1[0][dt][3] * inv); *(v2u*)(orow + 16 * dt) = w; }
    }
}

constexpr int CV_IN = (DM / 64) * (INW / 32), CV_OUT = (DM / 64) * (DM / 32), CV_GU = NEXP * 2 * (DM / 128) * (DFF / 32), CV_D = NEXP * (DFF / 128) * (DM / 32);
constexpr int CV_SMALL = CV_IN + CV_OUT, CV_ALL = CV_SMALL + CV_GU + CV_D;
constexpr int P1_ROUNDS = 4;
constexpr int CV_N1 = 28672, CV_N5 = 6144;
__device__ __forceinline__ void convert_item(const float* w_in, const float* w_out, int r, bf16* BTIN, bf16* BTOUT, LAS float* scr, int lane) {
    if (r < CV_IN) { const int nblk = INW / 32, kb = r / nblk, nb = r % nblk; transpose_item(w_in + (size_t)(64 * kb) * INW + win_src_col(32 * nb), INW, BTIN + (size_t)(32 * nb) * DM + 64 * kb, DM, scr, lane); return; }
    r -= CV_IN;
    { const int nblk = DM / 32, kb = r / nblk, nb = r % nblk; transpose_item(w_out + (size_t)(64 * kb) * DM + 32 * nb, DM, BTOUT + (size_t)(32 * nb) * DM + 64 * kb, DM, scr, lane); }
}
struct XItem { const float* src; unsigned char* dst; int ldw, ldd, f8; };
__device__ __forceinline__ XItem xitem(const float* w_gate, const float* w_up, const float* w_down, bf16* BTGU, bf16* BTD, int r) {
    XItem it;
    if (r < CV_GU) { const int per = (DM / 128) * (DFF / 32); const int e = r / (2 * per), r2 = r % (2 * per), which = r2 / per, r3 = r2 % per; const int nblk = DFF / 32, kb = r3 / nblk, nb = r3 % nblk;
        const float* W = (which ? w_up : w_gate) + (size_t)e * DM * DFF;
        const int f0 = 32 * nb, brow = 256 * (f0 >> 7) + 128 * which + (f0 & 127);
        it.src = W + (size_t)(128 * kb) * DFF + f0; it.ldw = DFF; it.dst = (unsigned char*)BTGU + ((size_t)e * 2048 + brow) * DM + 128 * kb; it.ldd = DM; it.f8 = 1; return it; }
    r -= CV_GU;
    { const int per = (DFF / 128) * (DM / 32); const int e = r / per, r3 = r % per; const int nblk = DM / 32, kb = r3 / nblk, nb = r3 % nblk;
        it.src = w_down + (size_t)e * DFF * DM + (size_t)(128 * kb) * DM + 32 * nb; it.ldw = DM; it.dst = (unsigned char*)BTD + ((size_t)e * DM + 32 * nb) * DFF + 128 * kb; it.ldd = DFF; it.f8 = 1; return it; }
}
__device__ __forceinline__ void convert_range(const float* w_gate, const float* w_up, const float* w_down, bf16* BTGU, bf16* BTD, int x0, int x1, LAS unsigned char* scr, int lane) {
    if (x0 >= x1) return;
    f32x4 ta[16], tc[16];
    XItem A = xitem(w_gate, w_up, w_down, BTGU, BTD, x0), B = A;
    t64_load(A.src, A.ldw, lane, ta);
#pragma unroll 1
    for (int x = x0; x < x1; x += 2) {
        const bool hasB = x + 1 < x1;
        if (hasB) { B = xitem(w_gate, w_up, w_down, BTGU, BTD, x + 1); t64_load(B.src, B.ldw, lane, tc); }
        t64_finish(ta, A.dst, A.ldd, A.f8, scr, lane);
        if (hasB) {
            if (x + 2 < x1) { A = xitem(w_gate, w_up, w_down, BTGU, BTD, x + 2); t64_load(A.src, A.ldw, lane, ta); }
            t64_finish(tc, B.dst, B.ldd, B.f8, scr, lane);
        }
    }
}

__global__ void __launch_bounds__(512, 2) hymba_fwd(Args args) {
    extern __shared__ __attribute__((aligned(16))) unsigned char lds_raw[];
    LAS unsigned char* lds = (LAS unsigned char*)lds_raw;
    const int wave = __builtin_amdgcn_readfirstlane(threadIdx.x >> 6);
#define TID() (wave * 64 + lane_id_v())
    const int G = gridDim.x, bx = blockIdx.x;
    unsigned char* ws = args.ws;
    gu32* ctl = (gu32*)(ws + WS_CTL);
    int* ltok = (int*)(ws + WS_LTOK); float* lw = (float*)(ws + WS_LW);
    bf16* BTIN = (bf16*)(ws + WS_BTIN); bf16* BTOUT = (bf16*)(ws + WS_BTOUT); bf16* XN = (bf16*)(ws + WS_XN); bf16* Ub = (bf16*)(ws + WS_U);
    bf16* Qb = (bf16*)(ws + WS_Q); bf16* Kb = (bf16*)(ws + WS_K); bf16* Vb = (bf16*)(ws + WS_V); bf16* MIX = (bf16*)(ws + WS_MIX); bf16* Hb = (bf16*)(ws + WS_H);
    bf16* BTGU = (bf16*)(ws + WS_BTGU); bf16* BTD = (bf16*)(ws + WS_BTD); bf16* Yb = (bf16*)(ws + WS_Y);
    volatile LAS unsigned* MISC = (volatile LAS unsigned*)(lds + MISC_OFF);
    { const int tid = TID(); if (tid < 16) MISC[tid] = 0u; }
    __syncthreads();
    XcdBarrier bar; bar.bar = (unsigned*)(ctl + CW_BAR); bar.x = 0; bar.st = nullptr;
    if (N_LAUNCHES == 1) bar = xcd_barrier_post((unsigned*)(ctl + CW_BAR), MISC, TID());
    const int lo = args.ph_lo, hi = args.ph_hi;
#define IN(k) (lo <= (k) && (k) < hi)
#define BOTH(k) (IN(k) && IN((k) + 1))
#define GRID_BAR() xcd_barrier(bar, TID())
    const int gw = bx * 8 + wave, NGW = G * 8;

    if (IN(0)) {
        const int lane = lane_id_v();
        LAS float* scr = (LAS float*)(lds + wave * 16384);
        for (int it = gw; it < CV_SMALL; it += NGW) convert_item(args.w_in, args.w_out, it, BTIN, BTOUT, scr, lane);
        for (int m = gw; m < SEQ; m += NGW) rms_row_to_bf16(args.x + (size_t)m * DM, args.norm1_g, XN + (size_t)m * DM, lane);
        {
            bf16* WRH = (bf16*)(ws + WS_WRH); bf16* WRL = (bf16*)(ws + WS_WRL);
            for (int idx = gw * 64 + lane; idx < 48 * DM; idx += NGW * 64) { const int j = idx / DM, d = idx % DM;
                float w = 0.f;
                if (j < 4) w = args.w_rg[d * NGRP + j]; else if (j < 36) w = args.w_re[((size_t)((j - 4) >> 3) * DM + d) * EPG + ((j - 4) & 7)];
                w *= args.norm2_g[d];
                const unsigned hi = f2bf(w); const float rem = w - __builtin_bit_cast(float, hi << 16);
                WRH[idx] = (bf16)hi; WRL[idx] = (bf16)f2bf(rem); }
        }
        if (BOTH(0)) GRID_BAR();
    }

    if (IN(1)) {
        const int units = (SEQ / 256) * (INW / 256), GG = (G >= 256) ? (units + P1_ROUNDS - 1) / P1_ROUNDS : G, FB = G - GG;
        if (bx < GG) {
            pg8::Gemm g{XN, BTIN, DM}; pg8::StaticOrder S; S.init(SEQ, INW, GG, bx);
            pg8::EpiInProj E{Ub, Qb, Kb, Vb, args.q_norm_g, args.k_norm_g};
            pg8::gemm_phase<pg8::EpiInProj, pg8::StaticOrder, true, false>(lds, g, S, E, nullptr, TID());
        }
        {   const int lane = lane_id_v();
            const int nb = FB > 0 ? FB : G, ti = FB > 0 ? bx - GG : bx;
            if (ti >= 0) { const int q = (CV_N1 + nb * 8 - 1) / (nb * 8), x0 = (ti * 8 + wave) * q, x1 = (x0 + q < CV_N1) ? x0 + q : CV_N1;
                convert_range(args.w_gate, args.w_up, args.w_down, BTGU, BTD, x0, x1, lds + wave * 8448, lane); }
        }
        if (BOTH(1)) GRID_BAR();
    }

    if (IN(2)) {
        LAS float* btab = (LAS float*)(lds + 8 * 12288);
        const int tid = TID(), lane = tid & 63;
        {
            float mq = 0.f, mk = 0.f;
            for (int d = 0; d < HD; ++d) { mq = fmaxf(mq, fabsf(args.q_norm_g[d])); mk = fmaxf(mk, fabsf(args.k_norm_g[d])); }
            for (int idx = tid; idx < NH * 3 * 132; idx += 512) { const int h = idx / 396, r2 = idx % 396, p = r2 / 132, rel = r2 % 132;
                float mb = 0.f; for (int b = 0; b < 32; ++b) mb = fmaxf(mb, fabsf(args.rel_bias[b * NH + h]));
                const float Mh = 1.02f * C2 * 64.f * mq * mk + mb * LOG2E;
                btab[idx] = args.rel_bias[(int)kBucket[p][rel] * NH + h] * LOG2E - Mh; }
        }
        __syncthreads();
        LAS unsigned char* vbuf = lds + wave * 12288;
        {
            constexpr int CV_LO = CV_N1, CV_HI = CV_GU + CV_D - CV_N5, CV_EXP = CV_HI - CV_LO;
            const int nA = (512 - bx + G - 1) / G;
            const int per_wave = (CV_EXP + NGW - 1) / NGW;
            const int c_lo = CV_LO + gw * per_wave, c_hi = (c_lo + per_wave < CV_HI) ? c_lo + per_wave : CV_HI;
            const int nsteps = nA > 0 ? nA : 1, per_batch = (per_wave + nsteps - 1) / nsteps;
            int ia = 0, ic = c_lo;
#pragma unroll 1
            for (int hs = 0; hs < 2 * nsteps; ++hs) {
                const bool doA = (((hs & 1) == 0) == (wave < 4));
                if (doA) { if (ia < nA) { const int a = bx + ia * G; const int blk = a >> 4, h = a & 15;
                        attn_wave(Qb, Kb, Vb, MIX, h, 256 * blk + wave, vbuf, btab + h * 396, lane); ++ia; } }
                else { const int ce = (ic + per_batch < c_hi) ? ic + per_batch : c_hi;
                    convert_range(args.w_gate, args.w_up, args.w_down, BTGU, BTD, ic, ce, vbuf, lane); ic = ce > ic ? ce : ic; }
            }
            convert_range(args.w_gate, args.w_up, args.w_down, BTGU, BTD, ic, c_hi, vbuf, lane);
        }
        __syncthreads();
        LAS float* cv = (LAS float*)lds;
        for (int ct = bx; ct < SEQ / 32; ct += G) {
            const int tb0 = 32 * ct, c0 = 2 * tid;
            float w0[CONVW], w1[CONVW];
#pragma unroll
            for (int j = 0; j < CONVW; ++j) { const f32x2 w = *(const f32x2*)(args.conv_w + j * CCH + c0); w0[j] = w.x; w1[j] = w.y; }
            const f32x2 cb = *(const f32x2*)(args.conv_b + c0);
            unsigned uw[62];
#pragma unroll
            for (int i = 0; i < 62; ++i) { const int tr = tb0 - 30 + i; uw[i] = (tr >= 0) ? *(const unsigned*)(Ub + (size_t)tr * CCH + c0) : 0u; }
#pragma unroll
            for (int i = 0; i < 32; ++i) { float a0 = cb.x, a1 = cb.y;
#pragma unroll
                for (int j = 0; j < CONVW; ++j) { a0 += w0[j] * bf_lo(uw[i + j]); a1 += w1[j] * bf_hi(uw[i + j]); }
                *(LAS f32x2*)(cv + i * CCH + c0) = (f32x2){a0, a1}; }
            __syncthreads();
#pragma unroll 1
            for (int i = wave; i < 32; i += 8) {
                f32x4 v[4]; float s = 0.f;
#pragma unroll
                for (int k = 0; k < 4; ++k) { v[k] = *(const LAS f32x4*)(cv + i * CCH + 4 * lane + 256 * k); s += (v[k].x + v[k].y) + (v[k].z + v[k].w); }
                const float mean = wave_sum(s) * (1.f / CCH); float s2 = 0.f;
#pragma unroll
                for (int k = 0; k < 4; ++k) { v[k] = v[k] - mean; s2 += (v[k].x * v[k].x + v[k].y * v[k].y) + (v[k].z * v[k].z + v[k].w * v[k].w); }
                const float rstd = __builtin_amdgcn_rsqf(wave_sum(s2) * (1.f / CCH) + NORM_EPS);
                bf16* orow = MIX + (size_t)(tb0 + i) * DM;
#pragma unroll
                for (int k = 0; k < 4; ++k) { const int c = 4 * lane + 256 * k; const f32x4 gg = *(const f32x4*)(args.conv_ln_g + c), bb = *(const f32x4*)(args.conv_ln_b + c);
                    f32x4 y = v[k] * rstd * gg + bb; y.x *= sigmoidf_(y.x); y.y *= sigmoidf_(y.y); y.z *= sigmoidf_(y.z); y.w *= sigmoidf_(y.w);
                    v2u w; w.x = pk2(y.x, y.y); w.y = pk2(y.z, y.w); *(v2u*)(orow + c) = w; }
            }
            __syncthreads();
        }
        if (BOTH(2)) GRID_BAR();
    }

    if (IN(3)) {
        pg8::Gemm g{MIX, BTOUT, DM}; pg8::StaticOrder S; S.init(SEQ, DM, G, bx);
        pg8::EpiResF32 E{args.x, args.out, XN, args.norm2_g};
        pg8::gemm_phase<pg8::EpiResF32, pg8::StaticOrder, true, false>(lds, g, S, E, nullptr, TID());
        if (BOTH(3)) GRID_BAR();
    }

    if (IN(4)) {
        const int tid = TID(), lane = tid & 63, li = lane & 15, kg = lane >> 4;
        LAS float* part = (LAS float*)lds;
        LAS float* logit = (LAS float*)(lds + 49152);
        LAS float* ssp = (LAS float*)(lds + 49152 + 6144);
        LAS float* rsl = ssp + 256;
        LAS int* selE = (LAS int*)(rsl + 32); LAS float* selW = (LAS float*)(selE + 64);
        int* tokpos = (int*)(ws + WS_TOKPOS); float* rstd_g = (float*)(ws + WS_RSTD);
        const bf16* WRH = (const bf16*)(ws + WS_WRH); const bf16* WRL = (const bf16*)(ws + WS_WRL);
        constexpr int NTILE = SEQ / 32;
        for (int tile = bx; tile < NTILE; tile += G) {
            const int t0 = 32 * tile;
            {
                const float* xp = args.out + (size_t)(t0 + li) * DM + 256 * wave + 8 * kg;
                const bf16* hp = WRH + (size_t)li * DM + 256 * wave + 8 * kg; const bf16* lp = WRL + (size_t)li * DM + 256 * wave + 8 * kg;
                f32x4 acc[2][3]; float ss[2] = {0.f, 0.f};
#pragma unroll
                for (int x = 0; x < 2; ++x)
#pragma unroll
                    for (int nt = 0; nt < 3; ++nt) acc[x][nt] = (f32x4){0.f, 0.f, 0.f, 0.f};
#pragma unroll 1
                for (int hf = 0; hf < 2; ++hf) {
                    f32x4 xa[2][4][2]; bf16x8 bh[4][3], bl[4][3];
#pragma unroll
                    for (int s4 = 0; s4 < 4; ++s4) { const int ko = 32 * (4 * hf + s4);
#pragma unroll
                        for (int x = 0; x < 2; ++x) { xa[x][s4][0] = *(const f32x4*)(xp + (size_t)(16 * x) * DM + ko); xa[x][s4][1] = *(const f32x4*)(xp + (size_t)(16 * x) * DM + ko + 4); }
#pragma unroll
                        for (int nt = 0; nt < 3; ++nt) { bh[s4][nt] = *(const bf16x8*)(hp + (size_t)(16 * nt) * DM + ko); bl[s4][nt] = *(const bf16x8*)(lp + (size_t)(16 * nt) * DM + ko); } }
                    asm volatile("s_waitcnt vmcnt(0)" ::: "memory"); __builtin_amdgcn_sched_barrier(0);
#pragma unroll
                    for (int s4 = 0; s4 < 4; ++s4)
#pragma unroll
                        for (int x = 0; x < 2; ++x) { const f32x4 a = xa[x][s4][0], b = xa[x][s4][1];
                            ss[x] += (a.x * a.x + a.y * a.y) + (a.z * a.z + a.w * a.w) + (b.x * b.x + b.y * b.y) + (b.z * b.z + b.w * b.w); }
                    __builtin_amdgcn_sched_barrier(0);
#pragma unroll
                    for (int s4 = 0; s4 < 4; ++s4)
#pragma unroll
                        for (int x = 0; x < 2; ++x) { const f32x4 a = xa[x][s4][0], b = xa[x][s4][1];
                            v4u h; h.x = cvt_pk_s(a.x, a.y); h.y = cvt_pk_s(a.z, a.w); h.z = cvt_pk_s(b.x, b.y); h.w = cvt_pk_s(b.z, b.w);
                            v4u l; l.x = cvt_pk_s(a.x - bf_lo(h.x), a.y - bf_hi(h.x)); l.y = cvt_pk_s(a.z - bf_lo(h.y), a.w - bf_hi(h.y));
                            l.z = cvt_pk_s(b.x - bf_lo(h.z), b.y - bf_hi(h.z)); l.w = cvt_pk_s(b.z - bf_lo(h.w), b.w - bf_hi(h.w));
                            const bf16x8 xh = __builtin_bit_cast(bf16x8, h), xl = __builtin_bit_cast(bf16x8, l);
#pragma unroll
                            for (int nt = 0; nt < 3; ++nt) {
                                acc[x][nt] = __builtin_amdgcn_mfma_f32_16x16x32_bf16(xl, bl[s4][nt], acc[x][nt], 0, 0, 0);
                                acc[x][nt] = __builtin_amdgcn_mfma_f32_16x16x32_bf16(xl, bh[s4][nt], acc[x][nt], 0, 0, 0);
                                acc[x][nt] = __builtin_amdgcn_mfma_f32_16x16x32_bf16(xh, bl[s4][nt], acc[x][nt], 0, 0, 0);
                                acc[x][nt] = __builtin_amdgcn_mfma_f32_16x16x32_bf16(xh, bh[s4][nt], acc[x][nt], 0, 0, 0); } }
                }
#pragma unroll
                for (int x = 0; x < 2; ++x) {
#pragma unroll
                    for (int nt = 0; nt < 3; ++nt)
#pragma unroll
                        for (int e = 0; e < 4; ++e) part[(wave * 32 + 16 * x + 4 * kg + e) * 48 + 16 * nt + li] = acc[x][nt][e];
                    float s1 = ss[x]; s1 += __shfl_xor(s1, 16); s1 += __shfl_xor(s1, 32);
                    if (kg == 0) ssp[wave * 32 + 16 * x + li] = s1; }
            }
            __syncthreads();
            for (int idx = tid; idx < 32 * 48; idx += 512) { float a = 0.f;
#pragma unroll
                for (int w8 = 0; w8 < 8; ++w8) a += part[w8 * 1536 + idx];
                logit[idx] = a; }
            if (tid < 32) { float a = 0.f;
#pragma unroll
                for (int w8 = 0; w8 < 8; ++w8) a += ssp[w8 * 32 + tid];
                const float r = __builtin_amdgcn_rsqf(a * (1.f / DM) + NORM_EPS); rsl[tid] = r; rstd_g[t0 + tid] = r; }
            __syncthreads();
            if (tid < 32) {
                const float rstd = rsl[tid]; const LAS float* lg = logit + tid * 48;
                int gidx = 0; float gmax = lg[0] * rstd + args.b_rg[0]; float glv[4]; glv[0] = gmax;
#pragma unroll
                for (int k = 1; k < 4; ++k) { glv[k] = lg[k] * rstd + args.b_rg[k]; if (glv[k] > gmax) { gmax = glv[k]; gidx = k; } }
                float gden = 0.f;
#pragma unroll
                for (int k = 0; k < 4; ++k) gden += __expf(glv[k] - gmax);
                const float gwt = 1.f / gden;
                int i0 = 0, i1 = -1; float v0 = -3.0e38f, v1 = -3.0e38f;
                for (int k = 0; k < 8; ++k) { const float v = lg[4 + 8 * gidx + k] * rstd + args.b_re[gidx * EPG + k];
                    if (v > v0) { v1 = v0; i1 = i0; v0 = v; i0 = k; } else if (v > v1) { v1 = v; i1 = k; } }
                const float p0 = 1.f / (1.f + __expf(v1 - v0)), p1 = 1.f - p0;
                selE[2 * tid] = gidx * EPG + i0; selE[2 * tid + 1] = gidx * EPG + i1; selW[2 * tid] = gwt * p0; selW[2 * tid + 1] = gwt * p1;
            }
            __syncthreads();
            if (wave == 0 && lane < NEXP) {
                const int e = lane; int cnt = 0;
                for (int i = 0; i < 64; ++i) cnt += (selE[i] == e) ? 1 : 0;
                unsigned base = 0u;
                if (cnt) base = __hip_atomic_fetch_add((unsigned*)(ctl + CW_CNT + 64 * e), (unsigned)cnt, RLX_AGENT);
                for (int i = 0; i < 64; ++i) if (selE[i] == e) { const int t = t0 + (i >> 1); ltok[e * SEQ + base] = t; lw[e * SEQ + base] = selW[i]; tokpos[2 * t + (i & 1)] = (e << 16) | (int)base; ++base; }
            }
            __syncthreads();
        }
        if (BOTH(4)) GRID_BAR();
    }

    if (IN(5) || IN(6) || IN(7)) {
        LAS int* mtok = (LAS int*)(lds + MOE_TOK_OFF); LAS float* mw = (LAS float*)(lds + MOE_W_OFF); LAS float* mr = (LAS float*)(lds + MOE_R_OFF); LAS int* tb = (LAS int*)(lds + MOE_TB_OFF);
        pg8::MoeOrder S{tb, G, bx};
        { const int tid = TID();
        if (tid == 0) { int acc = 0; for (int e = 0; e < NEXP; ++e) { const int c = (int)__hip_atomic_load((unsigned*)(ctl + CW_CNT + 64 * e), RLX_AGENT); tb[e] = acc; tb[33 + e] = c; acc += (c + 255) >> 8; } tb[32] = acc;
            int ok = (G == 256) ? 1 : 0, F = 0, rank = 0, mine = 0; const int x = bx & 7, j = bx >> 3;
            for (int xx = 0; xx < 8; ++xx) { int tx = 0; for (int k = 0; k < 4; ++k) tx += tb[xx + 8 * k + 1] - tb[xx + 8 * k]; if (tx > 12) ok = 0;
                int f = 8 * tx - 64; f = f < 0 ? 0 : (f > 32 ? 32 : f);
                F += 32 - f; int below = j + (xx < x ? 1 : 0) - f; below = below < 0 ? 0 : (below > 32 - f ? 32 - f : below); rank += below; if (xx == x) mine = (j >= f) ? 1 : 0; }
            tb[66] = ok; tb[67] = F; tb[68] = mine ? rank : -1;
            for (int i = 0; i < MAXU; ++i) { int T = -1, e = 0, n = 0;
                if (ok) { const int U = i * 32 + j, LT = U >> 3; n = U & 7; int cum = 0;
                    for (int k = 0; k < 4; ++k) { const int ee = x + 8 * k, t0 = tb[ee], nt = tb[ee + 1] - t0; if (T < 0 && LT < cum + nt) { e = ee; T = t0 + (LT - cum); } cum += nt; } }
                else { const int L = i * G + bx; if (L < acc * 8) { T = L >> 3; n = L & 7; for (int k = 1; k < 32; ++k) e += (tb[k] <= T) ? 1 : 0; } }
                tb[80 + 4 * i] = T; tb[81 + 4 * i] = e; tb[82 + 4 * i] = n; tb[83 + 4 * i] = T < 0 ? 0 : T - tb[e]; } }
        __syncthreads();
        for (int i = 0; i < MAXU; ++i) { pg8::Unit u; if (!S.next(i, u)) break;
            if (tid < 256) { const int idx = 256 * u.lt + tid; const bool valid = idx < tb[33 + u.e];
                const int tk = valid ? ltok[u.e * SEQ + idx] : -1;
                mtok[i * 256 + tid] = tk; mw[i * 256 + tid] = valid ? lw[u.e * SEQ + idx] : 0.f; mr[i * 256 + tid] = valid ? ((const float*)(ws + WS_RSTD))[tk] : 0.f; } }
        }
        __syncthreads();
        if (IN(5)) {
            pg8::Gemm g{XN, BTGU, DM / 2};
            pg8::EpiSwiGLU E{Hb, mw, mr};
            pg8::gemm_phase<pg8::EpiSwiGLU, pg8::MoeOrder, true, true, true>(lds, g, S, E, mtok, TID());
            {
                const int units = tb[32] * 8, rem = units % G; int tailb = rem > 0 ? G - rem : G, ti = rem > 0 ? bx - rem : bx;
                if (tb[66]) { if (tb[67] > 0) { tailb = tb[67]; ti = tb[68]; } else { tailb = G; ti = bx; } }
                if (ti >= 0) { const int lane = lane_id_v(); const int q = (CV_N5 + tailb * 8 - 1) / (tailb * 8), x0 = (ti * 8 + wave) * q, x1 = (x0 + q < CV_N5) ? x0 + q : CV_N5;
                    convert_range(args.w_gate, args.w_up, args.w_down, BTGU, BTD, CV_GU + CV_D - CV_N5 + x0, CV_GU + CV_D - CV_N5 + x1, lds + wave * 8448, lane); }
            }
            if (BOTH(5)) GRID_BAR();
        }
        if (IN(6)) {
            pg8::Gemm g{Hb, BTD, DFF / 2};
            pg8::EpiYStore E{Yb};
            pg8::gemm_phase<pg8::EpiYStore, pg8::MoeOrder, true, false, true>(lds, g, S, E, nullptr, TID());
            if (BOTH(6)) GRID_BAR();
        }
        if (IN(7)) {
            const int lane = lane_id_v();
            const int* tokpos = (const int*)(ws + WS_TOKPOS);
            for (int t = gw; t < SEQ; t += NGW) {
                const int c0 = tokpos[2 * t], c1 = tokpos[2 * t + 1];
                const size_t r0 = (size_t)(256 * tb[c0 >> 16] + (c0 & 0xffff)), r1 = (size_t)(256 * tb[c1 >> 16] + (c1 & 0xffff));
                const GAS f32x4* xo = (const GAS f32x4*)(args.out + (size_t)t * DM) + lane; GAS f32x4* xw = (GAS f32x4*)(args.out_w + (size_t)t * DM) + lane;
                const GAS v2u* y0 = (const GAS v2u*)(Yb + r0 * DM) + lane; const GAS v2u* y1 = (const GAS v2u*)(Yb + r1 * DM) + lane;
#pragma unroll
                for (int j = 0; j < 8; ++j) { f32x4 a = __builtin_nontemporal_load(xo + 64 * j); const v2u b0 = __builtin_nontemporal_load(y0 + 64 * j), b1 = __builtin_nontemporal_load(y1 + 64 * j);
                    a.x = (a.x + bf_lo(b0.x)) + bf_lo(b1.x); a.y = (a.y + bf_hi(b0.x)) + bf_hi(b1.x); a.z = (a.z + bf_lo(b0.y)) + bf_lo(b1.y); a.w = (a.w + bf_hi(b0.y)) + bf_hi(b1.y);
                    __builtin_nontemporal_store(a, xw + 64 * j); }
            }
        }
    }
#undef IN
#undef BOTH
#undef GRID_BAR
#undef TID
}

extern "C" void kernel_launch(void* const* d_in, const int* in_sizes, int n_in, void* d_out, int out_size, void* d_ws, size_t ws_size, hipStream_t stream) {
    static int grid = 0;
    if (grid == 0) {
        if (n_in != 19 || out_size != SEQ * DM || ws_size < WS_END) { fprintf(stderr, "kernel_launch: unexpected sizes (n_in %d out %d ws %zu)\n", n_in, out_size, ws_size); grid = -1; return; }
        int dev = 0, cus = 0, per_cu = 0;
        if (hipGetDevice(&dev) != hipSuccess || hipDeviceGetAttribute(&cus, hipDeviceAttributeMultiprocessorCount, dev) != hipSuccess) { grid = -1; return; }
        if (hipFuncSetAttribute((const void*)hymba_fwd, hipFuncAttributeMaxDynamicSharedMemorySize, LDS_BYTES) != hipSuccess) { fprintf(stderr, "kernel_launch: hipFuncSetAttribute failed\n"); grid = -1; return; }
        if (hipOccupancyMaxActiveBlocksPerMultiprocessor(&per_cu, (const void*)hymba_fwd, 512, LDS_BYTES) != hipSuccess || per_cu < 1) fprintf(stderr, "kernel_launch: occupancy query reports %d\n", per_cu);
        (void)hipGetLastError();
        grid = cus;
    }
    if (grid < 0) return;
    if (hipMemsetAsync((char*)d_ws + WS_CTL, 0, CTL_ZERO_BYTES, stream) != hipSuccess) return;
    Args a{};
    a.x = (const float*)d_in[0]; a.norm1_g = (const float*)d_in[1]; a.w_in = (const float*)d_in[2]; a.q_norm_g = (const float*)d_in[3]; a.k_norm_g = (const float*)d_in[4];
    a.conv_w = (const float*)d_in[5]; a.conv_b = (const float*)d_in[6]; a.conv_ln_g = (const float*)d_in[7]; a.conv_ln_b = (const float*)d_in[8]; a.rel_bias = (const float*)d_in[9];
    a.w_out = (const float*)d_in[10]; a.norm2_g = (const float*)d_in[11]; a.w_rg = (const float*)d_in[12]; a.b_rg = (const float*)d_in[13]; a.w_re = (const float*)d_in[14]; a.b_re = (const float*)d_in[15];
    a.w_gate = (const float*)d_in[16]; a.w_up = (const float*)d_in[17]; a.w_down = (const float*)d_in[18];
    a.out = (float*)d_out; a.out_w = (float*)d_out; a.ws = (unsigned char*)d_ws;
    if (N_LAUNCHES == 1) { a.ph_lo = 0; a.ph_hi = N_PHASES; hipLaunchKernelGGL(hymba_fwd, dim3(grid), dim3(512), LDS_BYTES, stream, a); }
    else {
#ifndef MK_PROBE
#define MK_PROBE -1
#endif
        for (int p = 0; p < N_PHASES; ++p) { a.ph_lo = p; a.ph_hi = p + 1; hipLaunchKernelGGL(hymba_fwd, dim3(grid), dim3(512), LDS_BYTES, stream, a);
            if (p == MK_PROBE) { Args b = a;
                if (p == 7) b.out_w = (float*)((char*)d_ws + WS_Q);
                if (p == 4) { b.ws = (unsigned char*)d_ws + 700 * MiB; (void)hipMemsetAsync(b.ws, 0, CTL_ZERO_BYTES, stream); }
                hipLaunchKernelGGL(hymba_fwd, dim3(grid), dim3(512), LDS_BYTES, stream, b); } }
    }
}
```

```cpp
#include <hip/hip_runtime.h>
#include <cstdio>
#include <cstdint>

#ifndef MK_N_LAUNCHES
#define MK_N_LAUNCHES 1
#endif
constexpr int N_LAUNCHES = MK_N_LAUNCHES;
constexpr int N_PHASES = 8;

#define GAS __attribute__((address_space(1)))
#define LAS __attribute__((address_space(3)))
typedef unsigned short bf16;
typedef unsigned v4u __attribute__((ext_vector_type(4)));
typedef unsigned v2u __attribute__((ext_vector_type(2)));
typedef float f32x4 __attribute__((ext_vector_type(4)));
typedef float f32x2 __attribute__((ext_vector_type(2)));
typedef short bf16x8 __attribute__((ext_vector_type(8)));
typedef short s16x4 __attribute__((ext_vector_type(4)));
typedef GAS unsigned gu32;
typedef int v8i __attribute__((ext_vector_type(8)));
typedef int v4i __attribute__((ext_vector_type(4)));
#define RLX_AGENT __ATOMIC_RELAXED, __HIP_MEMORY_SCOPE_AGENT
#define LDS_WAIT() asm volatile("s_waitcnt lgkmcnt(0)" ::: "memory")
#define VM_WAIT() asm volatile("s_waitcnt vmcnt(0)" ::: "memory")

constexpr int SEQ = 8192, DM = 2048, CCH = 1024, AW = 1024, NH = 16, HD = 64, INW = 5120, CONVW = 31;
constexpr int NGRP = 4, EPG = 8, NEXP = 32, DFF = 1024;
constexpr float NORM_EPS = 1e-6f;
constexpr float LOG2E = 1.4426950408889634f;
constexpr float C2 = 0.125f * LOG2E;
constexpr int MAXT = 96;
constexpr int MAXU = 3;

constexpr size_t MiB = 1u << 20;
constexpr size_t WS_CTL = 0, CTL_ZERO_BYTES = 40960;
constexpr size_t WS_LTOK = 1 * MiB;
constexpr size_t WS_LW = 2 * MiB;
constexpr size_t WS_BTIN = 4 * MiB;
constexpr size_t WS_BTOUT = 24 * MiB;
constexpr size_t WS_XN = 32 * MiB;
constexpr size_t WS_U = 64 * MiB;
constexpr size_t WS_Q = 80 * MiB, WS_K = 96 * MiB, WS_V = 112 * MiB;
constexpr size_t WS_MIX = 128 * MiB;
constexpr size_t WS_H = 160 * MiB;
constexpr size_t WS_BTGU = 208 * MiB;
constexpr size_t WS_BTD = 464 * MiB;
constexpr size_t WS_Y = 592 * MiB;
constexpr size_t WS_END = 688 * MiB;
constexpr size_t WS_TOKPOS = 3 * MiB;
constexpr size_t WS_RSTD = 3 * MiB + 65536;
constexpr size_t WS_WRH = 3 * MiB + 131072;
constexpr size_t WS_WRL = WS_WRH + 48 * 2048 * 2;
constexpr int CW_BAR = 0;
constexpr int CW_CNT = 4096;
static_assert((CW_CNT + 64 * 32) * 4 <= (int)CTL_ZERO_BYTES && 3456 <= CW_CNT, "control words inside the zeroed region");

constexpr int RING_BYTES = 131072;
constexpr int MOE_TOK_OFF = RING_BYTES;
constexpr int MOE_W_OFF = MOE_TOK_OFF + MAXU * 1024;
constexpr int MOE_R_OFF = MOE_W_OFF + MAXU * 1024;
constexpr int MOE_TB_OFF = MOE_R_OFF + MAXU * 1024;
constexpr int MISC_OFF = MOE_TB_OFF + 512;
constexpr int LDS_BYTES = 147456;
static_assert(MISC_OFF + 64 <= LDS_BYTES, "LDS map");

__device__ __forceinline__ unsigned f2bf(float f) { unsigned u = __builtin_bit_cast(unsigned, f); return (u + 0x7fffu + ((u >> 16) & 1u)) >> 16; }
__device__ __forceinline__ unsigned pk2(float lo, float hi) { return f2bf(lo) | (f2bf(hi) << 16); }
__device__ __forceinline__ unsigned cvt_pk_bf16(float lo, float hi) { unsigned r; asm volatile("v_cvt_pk_bf16_f32 %0, %1, %2" : "=v"(r) : "v"(lo), "v"(hi)); return r; }
typedef __bf16 bf16x2_t __attribute__((ext_vector_type(2)));
__device__ __forceinline__ unsigned cvt_pk_s(float lo, float hi) { const f32x2 v = {lo, hi}; const bf16x2_t b = __builtin_convertvector(v, bf16x2_t); return __builtin_bit_cast(unsigned, b); }
__device__ __forceinline__ unsigned pk4_fp8(float a, float b, float c, float d) { int p = 0; p = __builtin_amdgcn_cvt_pk_fp8_f32(a, b, p, false); p = __builtin_amdgcn_cvt_pk_fp8_f32(c, d, p, true); return (unsigned)p; }
constexpr float W8_SCALE = 64.f, H8_SCALE = 16.f;
__device__ __forceinline__ float bf_lo(unsigned u) { return __builtin_bit_cast(float, u << 16); }
__device__ __forceinline__ float bf_hi(unsigned u) { return __builtin_bit_cast(float, u & 0xffff0000u); }
__device__ __forceinline__ float sigmoidf_(float x) { return __builtin_amdgcn_rcpf(1.f + __expf(-x)); }
__device__ __forceinline__ int lane_id_v() { int l; asm volatile("v_mbcnt_lo_u32_b32 %0, -1, 0\n\tv_mbcnt_hi_u32_b32 %0, -1, %0" : "=v"(l)); return l; }
__device__ __forceinline__ float wave_sum(float v) {
#pragma unroll
    for (int o = 1; o < 64; o <<= 1) v += __shfl_xor(v, o);
    return v;
}

__constant__ unsigned char kBucket[3][132] = {
 {0,1,2,3,4,5,6,7,8,9,10,11,12,13,14,15,16,16,16,16,16,16,17,17,17,17,17,17,17,17,18,18,18,18,18,18,18,18,18,18,19,19,19,19,19,19,19,19,19,19,19,19,19,19,20,20,20,20,20,20,20,20,20,20,20,20,20,20,20,20,20,20,20,21,21,21,21,21,21,21,21,21,21,21,21,21,21,21,21,21,21,21,21,21,21,21,21,21,21,22,22,22,22,22,22,22,22,22,22,22,22,22,22,22,22,22,22,22,22,22,22,22,22,22,22,22,22,22,22,0,0,0},
 {0,4,8,12,16,16,17,17,18,18,19,19,19,19,20,20,20,20,20,21,21,21,21,21,21,22,22,22,22,22,22,22,22,22,23,23,23,23,23,23,23,23,23,23,23,23,24,24,24,24,24,24,24,24,24,24,24,24,24,24,24,24,25,25,25,25,25,25,25,25,25,25,25,25,25,25,25,25,25,25,25,25,25,26,26,26,26,26,26,26,26,26,26,26,26,26,26,26,26,26,26,26,26,26,26,26,26,26,26,26,26,26,26,27,27,27,27,27,27,27,27,27,27,27,27,27,27,27,27,0,0,0},
 {0,16,18,19,20,21,21,22,22,23,23,23,24,24,24,24,25,25,25,25,25,26,26,26,26,26,26,26,26,27,27,27,27,27,27,27,27,27,27,28,28,28,28,28,28,28,28,28,28,28,28,28,29,29,29,29,29,29,29,29,29,29,29,29,29,29,29,29,29,29,30,30,30,30,30,30,30,30,30,30,30,30,30,30,30,30,30,30,30,30,30,30,30,30,30,31,31,31,31,31,31,31,31,31,31,31,31,31,31,31,31,31,31,31,31,31,31,31,31,31,31,31,31,31,31,31,31,31,31,0,0,0}};

namespace pg8 {
constexpr int BM = 256, BK = 64, HALF = 128, HTB = HALF * BK * 2, STAGE_BYTES = 8 * HTB, NXCD = 8, WGM = 8;
__host__ __device__ __forceinline__ int lds_byte(int r, int c) { const int st = (r >> 4) * 2 + (c >> 5), rr = r & 15, cc = c & 31, ob = rr * 64 + cc * 2; return st * 1024 + (ob ^ (((ob >> 9) & 1) << 5)); }
__host__ __device__ __forceinline__ void stage_rc(int b, int& R, int& C) { const int st = b / 1024, sb = b % 1024, swz = sb ^ (((sb >> 9) & 1) << 5); R = (st >> 1) * 16 + swz / 64; C = (st & 1) * 32 + (swz % 64) / 2; }
__host__ __device__ __forceinline__ int perm32(int rho) { const int n = rho >> 4, i = rho & 15; return 8 * (i >> 2) + 4 * n + (i & 3); }

struct Unit { int pm, pn, e, lt, slot; };
struct Gemm { const bf16* A; const bf16* Bt; int K; };

struct StaticOrder {
    int nM, nN, nwg, G, c;
    __host__ __device__ void init(int M, int N, int G_, int c_) { nM = M / BM; nN = N / BM; nwg = nM * nN; G = G_; c = c_; }
    __host__ __device__ bool next(int i, Unit& u) const {
        const long L = (long)i * G + c; if (L >= nwg) return false;
        int wgid = (int)L; { const int q = nwg / NXCD, r = nwg % NXCD, xcd = wgid % NXCD, off = wgid / NXCD; wgid = (xcd < r ? xcd * (q + 1) : r * (q + 1) + (xcd - r) * q) + off; }
        const int nig = WGM * nN, gid = wgid / nig, fm = gid * WGM, gsz = (nM - fm) < WGM ? (nM - fm) : WGM;
        u.pm = fm + ((wgid % nig) % gsz); u.pn = (wgid % nig) / gsz; u.e = 0; u.lt = 0; u.slot = i; return true;
    }
};
struct MoeOrder {
    const LAS int* tb; int G, c;
    __device__ __forceinline__ bool next(int i, Unit& u) const {
        if (i >= MAXU) return false;
        const int T = __builtin_amdgcn_readfirstlane(tb[80 + 4 * i]); if (T < 0) return false;
        const int e = __builtin_amdgcn_readfirstlane(tb[81 + 4 * i]), n = __builtin_amdgcn_readfirstlane(tb[82 + 4 * i]);
        u.pm = T; u.pn = e * 8 + n; u.e = e; u.lt = __builtin_amdgcn_readfirstlane(tb[83 + 4 * i]); u.slot = i; return true;
    }
};

template <class Epi, class Sched, bool ALIGN_EPI, bool GATHER, bool F8 = false>
__device__ __forceinline__ void gemm_phase(LAS unsigned char* lds, const Gemm g, const Sched& S, const Epi& E, const LAS int* gtok, const int tid) {
    const int wid = __builtin_amdgcn_readfirstlane(tid >> 6), lane = tid & 63, wr = wid >> 2, wc = wid & 3, fr = lane & 15, fq = lane >> 4;
    const int K = g.K, nt = K / BK;
    const size_t kstep = (size_t)(BK * 2);
    const size_t hstep = (size_t)HALF * K * 2;
    const size_t tstep = 2 * hstep;
    unsigned voffB[2], vA[2][2];
#pragma unroll
    for (int i = 0; i < 2; ++i) { int R, C; stage_rc(tid * 16 + i * 8192, R, C); const int Rb = Epi::PERM ? ((R & ~31) + perm32(R & 31)) : R;
        voffB[i] = (unsigned)(Rb * K + C) * 2u;
        vA[0][i] = (unsigned)(R * K + C) * 2u; vA[1][i] = vA[0][i] + (unsigned)hstep; }
    const unsigned ldsw = (unsigned)wid * 1024u;
    const int aoff = lds_byte(wr * 64 + fr, fq * 8), boff = lds_byte(wc * 32 + fr, fq * 8);
#define PG8_SA(b, h) (((b) * 2 + (h)) * HTB)
#define PG8_SB(b, h) ((4 + (b) * 2 + (h)) * HTB)
#define PG8_STAGE(bufoff, gbase, voff) do { const char* _gb = (const char*)(gbase); asm volatile("" : "+s"(_gb)); _Pragma("unroll") for (int _i = 0; _i < 2; ++_i) { unsigned _vo = (voff)[_i]; asm volatile("" : "+v"(_vo)); \
        __builtin_amdgcn_global_load_lds((const unsigned*)(_gb + _vo), (LAS unsigned*)(lds + (bufoff) + ldsw + _i * 8192), 16, 0, 0); } } while (0)
#define PG8_GLOAD(v, slot_) do { const int _t = wid * 64 + lane_id_v(); _Pragma("unroll") for (int _i = 0; _i < 2; ++_i) { int _R, _C; stage_rc(_t * 16 + _i * 8192, _R, _C); \
        _Pragma("unroll") for (int _h = 0; _h < 2; ++_h) { int _tk = gtok[(slot_) * 256 + 128 * _h + _R]; _tk = _tk < 0 ? 0 : _tk; v[_h][_i] = (unsigned)(_tk * K + _C) * 2u; } } } while (0)
#define PG8_LDA(dst, b, h) do { if constexpr (F8) { _Pragma("unroll") for (int m = 0; m < 4; ++m) { const v4i _lo = *(const LAS v4i*)(lds + PG8_SA(b, h) + aoff + m * 2048), _hi = *(const LAS v4i*)(lds + PG8_SA(b, h) + aoff + m * 2048 + 1024); \
            dst##8[m] = __builtin_shufflevector(_lo, _hi, 0, 1, 2, 3, 4, 5, 6, 7); } } \
        else { _Pragma("unroll") for (int m = 0; m < 4; ++m) _Pragma("unroll") for (int k = 0; k < 2; ++k) dst[m][k] = *(const LAS bf16x8*)(lds + PG8_SA(b, h) + aoff + m * 2048 + k * 1024); } } while (0)
#define PG8_LDB(dst, b, h) do { if constexpr (F8) { _Pragma("unroll") for (int n = 0; n < 2; ++n) { const v4i _lo = *(const LAS v4i*)(lds + PG8_SB(b, h) + boff + n * 2048), _hi = *(const LAS v4i*)(lds + PG8_SB(b, h) + boff + n * 2048 + 1024); \
            dst##8[n] = __builtin_shufflevector(_lo, _hi, 0, 1, 2, 3, 4, 5, 6, 7); } } \
        else { _Pragma("unroll") for (int n = 0; n < 2; ++n) _Pragma("unroll") for (int k = 0; k < 2; ++k) dst[n][k] = *(const LAS bf16x8*)(lds + PG8_SB(b, h) + boff + n * 2048 + k * 1024); } } while (0)
#define PG8_MMA(ai, bj, At, Bt) do { __builtin_amdgcn_s_setprio(1); \
        if constexpr (F8) { _Pragma("unroll") for (int m = 0; m < 4; ++m) _Pragma("unroll") for (int n = 0; n < 2; ++n) \
            acc[ai][bj][m][n] = __builtin_amdgcn_mfma_scale_f32_16x16x128_f8f6f4(Bt##8[n], At##8[m], acc[ai][bj][m][n], 0, 0, 0, 0x7f7f7f7f, 0, 0x7f7f7f7f); } \
        else { _Pragma("unroll") for (int m = 0; m < 4; ++m) _Pragma("unroll") for (int n = 0; n < 2; ++n) _Pragma("unroll") for (int k = 0; k < 2; ++k) \
            acc[ai][bj][m][n] = __builtin_amdgcn_mfma_f32_16x16x32_bf16(Bt[n][k], At[m][k], acc[ai][bj][m][n], 0, 0, 0); } \
        __builtin_amdgcn_s_setprio(0); } while (0)
#define PG8_WAIT_V(n) asm volatile("s_waitcnt vmcnt(" #n ")" ::: "memory")
#define PG8_WAIT_L(n) asm volatile("s_waitcnt lgkmcnt(" #n ")" ::: "memory")
#define PG8_BAR __builtin_amdgcn_s_barrier()
#define PG8_SCHED __builtin_amdgcn_sched_barrier(0)
    Unit cur, nxt; int ui = 0;
    if (!S.next(0, cur)) return;
    f32x4 acc[2][2][4][2];
#pragma unroll
    for (int a = 0; a < 2; ++a)
#pragma unroll
        for (int b = 0; b < 2; ++b)
#pragma unroll
            for (int m = 0; m < 4; ++m)
#pragma unroll
                for (int n = 0; n < 2; ++n) acc[a][b][m][n] = (f32x4){0.f, 0.f, 0.f, 0.f};
    bf16x8 At[4][2], B0[2][2], B1[2][2]; v8i At8[4], B08[2], B18[2];
    const char* cA = GATHER ? (const char*)g.A : (const char*)g.A + (size_t)cur.pm * tstep; const char* cB = (const char*)g.Bt + (size_t)cur.pn * tstep;
    if constexpr (GATHER) { PG8_GLOAD(vA, cur.slot); }
    PG8_STAGE(PG8_SB(0, 0), cB, voffB); PG8_STAGE(PG8_SB(0, 1), cB + hstep, voffB); PG8_STAGE(PG8_SA(0, 0), cA, vA[0]); PG8_STAGE(PG8_SA(0, 1), cA, vA[1]);
    if (wr == 1) PG8_BAR;
    PG8_WAIT_V(2); PG8_BAR;
    PG8_STAGE(PG8_SB(1, 0), cB + kstep, voffB); PG8_STAGE(PG8_SA(1, 0), cA + kstep, vA[0]); PG8_STAGE(PG8_SB(1, 1), cB + hstep + kstep, voffB);
    PG8_WAIT_V(6); PG8_BAR;
    for (;;) {
        const bool has_next = S.next(ui + 1, nxt);
        const char* nA = GATHER ? cA : (has_next ? (const char*)g.A + (size_t)nxt.pm * tstep : cA); const char* nB = has_next ? (const char*)g.Bt + (size_t)nxt.pn * tstep : cB;

#pragma unroll 1
        for (int t = 0; t < nt; t += 2) {
            const bool last = (t == nt - 2);
            const char* a1 = cA + (size_t)(t + 1) * kstep;
            const char* a2 = last ? nA : cA + (size_t)(t + 2) * kstep; const char* b2 = last ? nB : cB + (size_t)(t + 2) * kstep;
            const char* a3 = a2 + kstep; const char* b3 = b2 + kstep;
            unsigned vS[2][2];
#pragma unroll
            for (int h = 0; h < 2; ++h)
#pragma unroll
                for (int i = 0; i < 2; ++i) vS[h][i] = vA[h][i];
            if constexpr (GATHER) { if (last && has_next) { PG8_GLOAD(vS, nxt.slot); } }

            PG8_LDB(B0, 0, 0); PG8_LDB(B1, 0, 1); PG8_SCHED; PG8_LDA(At, 0, 0); PG8_STAGE(PG8_SA(1, 1), a1, vA[1]);
            PG8_WAIT_V(8); PG8_WAIT_L(0); PG8_BAR; PG8_MMA(0, 0, At, B0); PG8_MMA(0, 1, At, B1); PG8_BAR; PG8_SCHED;
            PG8_LDA(At, 0, 1); PG8_STAGE(PG8_SB(0, 0), b2, voffB); PG8_STAGE(PG8_SB(0, 1), b2 + hstep, voffB); PG8_STAGE(PG8_SA(0, 0), a2, vS[0]);
            PG8_WAIT_V(8); PG8_WAIT_L(0); PG8_BAR; PG8_MMA(1, 0, At, B0); PG8_MMA(1, 1, At, B1); PG8_BAR; PG8_SCHED;
            PG8_LDB(B0, 1, 0); PG8_LDB(B1, 1, 1); PG8_SCHED; PG8_LDA(At, 1, 0); PG8_STAGE(PG8_SA(0, 1), a2, vS[1]);
            PG8_WAIT_V(8); PG8_WAIT_L(0); PG8_BAR; PG8_MMA(0, 0, At, B0); PG8_MMA(0, 1, At, B1); PG8_BAR; PG8_SCHED;
            PG8_LDA(At, 1, 1); PG8_STAGE(PG8_SB(1, 0), b3, voffB); PG8_STAGE(PG8_SB(1, 1), b3 + hstep, voffB); PG8_STAGE(PG8_SA(1, 0), a3, vS[0]);
            PG8_WAIT_V(8); PG8_WAIT_L(0); PG8_BAR; PG8_MMA(1, 0, At, B0); PG8_MMA(1, 1, At, B1); PG8_BAR; PG8_SCHED;
        }
        if constexpr (ALIGN_EPI) { if (wr == 0) PG8_BAR; }
        { const int _l = lane_id_v();
          E(acc, cur, wr, wc, _l & 15, _l >> 4); }
        if (!has_next) break;
#pragma unroll
        for (int a = 0; a < 2; ++a)
#pragma unroll
            for (int b = 0; b < 2; ++b)
#pragma unroll
                for (int m = 0; m < 4; ++m)
#pragma unroll
                    for (int n = 0; n < 2; ++n) acc[a][b][m][n] = (f32x4){0.f, 0.f, 0.f, 0.f};
        cur = nxt; cA = nA; cB = nB; ++ui;
        if constexpr (GATHER) { PG8_GLOAD(vA, cur.slot); }
        if constexpr (ALIGN_EPI) { if (wr == 1) PG8_BAR; }
    }
    PG8_WAIT_V(0);
    if constexpr (!ALIGN_EPI) { if (wr == 0) PG8_BAR; }
    PG8_BAR;
#undef PG8_SA
#undef PG8_SB
#undef PG8_STAGE
#undef PG8_GLOAD
#undef PG8_LDA
#undef PG8_LDB
#undef PG8_MMA
#undef PG8_WAIT_V
#undef PG8_WAIT_L
#undef PG8_BAR
#undef PG8_SCHED
}

typedef const f32x4 (&AccRef)[2][2][4][2];
struct EpiInProj {
    static constexpr bool PERM = true;
    bf16 *U, *Q, *Kb, *V; const float *qg, *kg;
    __device__ __forceinline__ void operator()(AccRef acc, const Unit& u, int wr, int wc, int fr, int fq) const {
        const int row0 = u.pm * BM + wr * 64 + fr;
        if (u.pn < 8) {
#pragma unroll
            for (int ai = 0; ai < 2; ++ai)
#pragma unroll
                for (int m = 0; m < 4; ++m) { const int r = row0 + ai * HALF + m * 16;
                    f32x4 a0 = acc[ai][0][m][0], a1 = acc[ai][0][m][1], g0 = acc[ai][1][m][0], g1 = acc[ai][1][m][1];
                    v4u w; w.x = cvt_pk_bf16(a0[0] * sigmoidf_(g0[0]), a0[1] * sigmoidf_(g0[1])); w.y = cvt_pk_bf16(a0[2] * sigmoidf_(g0[2]), a0[3] * sigmoidf_(g0[3]));
                    w.z = cvt_pk_bf16(a1[0] * sigmoidf_(g1[0]), a1[1] * sigmoidf_(g1[1])); w.w = cvt_pk_bf16(a1[2] * sigmoidf_(g1[2]), a1[3] * sigmoidf_(g1[3]));
                    *(v4u*)(U + (size_t)r * CCH + 128 * u.pn + 32 * wc + 8 * fq) = w; }
        } else if (u.pn < 16) {
            const int t = u.pn - 8, tensor = t >> 2, head = 4 * (t & 3) + wc;
            const float* gn = tensor ? kg : qg; bf16* dst = tensor ? Kb : Q; const float sc0 = tensor ? 1.f : C2;
            f32x4 gv[2][2];
#pragma unroll
            for (int bj = 0; bj < 2; ++bj)
#pragma unroll
                for (int n = 0; n < 2; ++n) gv[bj][n] = *(const f32x4*)(gn + 32 * bj + 8 * fq + 4 * n);
#pragma unroll
            for (int ai = 0; ai < 2; ++ai)
#pragma unroll
                for (int m = 0; m < 4; ++m) { const int r = row0 + ai * HALF + m * 16; float ss = 0.f;
#pragma unroll
                    for (int bj = 0; bj < 2; ++bj)
#pragma unroll
                        for (int n = 0; n < 2; ++n) { const f32x4 v = acc[ai][bj][m][n]; ss += (v[0] * v[0] + v[1] * v[1]) + (v[2] * v[2] + v[3] * v[3]); }
                    ss += __shfl_xor(ss, 16); ss += __shfl_xor(ss, 32);
                    const float sc = sc0 * __builtin_amdgcn_rsqf(ss * (1.f / 64.f) + NORM_EPS);
#pragma unroll
                    for (int bj = 0; bj < 2; ++bj) { const f32x4 v0 = acc[ai][bj][m][0] * gv[bj][0] * sc, v1 = acc[ai][bj][m][1] * gv[bj][1] * sc;
                        v4u w; w.x = cvt_pk_bf16(v0[0], v0[1]); w.y = cvt_pk_bf16(v0[2], v0[3]); w.z = cvt_pk_bf16(v1[0], v1[1]); w.w = cvt_pk_bf16(v1[2], v1[3]);
                        *(v4u*)(dst + (size_t)r * AW + 64 * head + 32 * bj + 8 * fq) = w; } }
        } else {
            const int cb = 256 * (u.pn - 16) + 32 * wc + 8 * fq;
#pragma unroll
            for (int ai = 0; ai < 2; ++ai)
#pragma unroll
                for (int m = 0; m < 4; ++m) { const int r = row0 + ai * HALF + m * 16;
#pragma unroll
                    for (int bj = 0; bj < 2; ++bj) { const f32x4 v0 = acc[ai][bj][m][0], v1 = acc[ai][bj][m][1];
                        v4u w; w.x = cvt_pk_bf16(v0[0], v0[1]); w.y = cvt_pk_bf16(v0[2], v0[3]); w.z = cvt_pk_bf16(v1[0], v1[1]); w.w = cvt_pk_bf16(v1[2], v1[3]);
                        *(v4u*)(V + (size_t)r * AW + cb + 128 * bj) = w; } }
        }
    }
};
struct EpiResF32 {
    static constexpr bool PERM = true;
    const float* X; bf16* O; bf16* HN; const float* g2;
    __device__ __forceinline__ void operator()(AccRef acc, const Unit& u, int wr, int wc, int fr, int fq) const {
        const int row0 = u.pm * BM + wr * 64 + fr, col0 = u.pn * BM + wc * 32 + 8 * fq;
        f32x4 gv[2][2];
#pragma unroll
        for (int bj = 0; bj < 2; ++bj)
#pragma unroll
            for (int n = 0; n < 2; ++n) gv[bj][n] = *(const f32x4*)(g2 + col0 + bj * HALF + 4 * n);
#pragma unroll
        for (int ai = 0; ai < 2; ++ai)
#pragma unroll
            for (int m = 0; m < 4; ++m) { const size_t ro = (size_t)(row0 + ai * HALF + m * 16) * DM + col0;
                f32x4 xv[2][2];
#pragma unroll
                for (int bj = 0; bj < 2; ++bj)
#pragma unroll
                    for (int n = 0; n < 2; ++n) xv[bj][n] = __builtin_nontemporal_load((const f32x4*)(X + ro + bj * HALF + 4 * n));
#pragma unroll
                for (int bj = 0; bj < 2; ++bj) { const f32x4 a = xv[bj][0] + acc[ai][bj][m][0], b = xv[bj][1] + acc[ai][bj][m][1];
                    { v4u xo; xo.x = cvt_pk_bf16(a[0], a[1]); xo.y = cvt_pk_bf16(a[2], a[3]); xo.z = cvt_pk_bf16(b[0], b[1]); xo.w = cvt_pk_bf16(b[2], b[3]); *(v4u*)(O + ro + bj * HALF) = xo; }
                    const f32x4 ha = a * gv[bj][0], hb = b * gv[bj][1];
                    v2u w; w.x = pk4_fp8(ha[0], ha[1], ha[2], ha[3]); w.y = pk4_fp8(hb[0], hb[1], hb[2], hb[3]);
                    *(v2u*)((unsigned char*)HN + ro + bj * HALF) = w; } }
    }
};
struct EpiSwiGLU {
    static constexpr bool PERM = true;
    bf16* H; const LAS float* wts; const LAS float* rs;
    __device__ __forceinline__ void operator()(AccRef acc, const Unit& u, int wr, int wc, int fr, int fq) const {
        const int cb = 128 * (u.pn & 7) + 32 * wc + 8 * fq;
#pragma unroll
        for (int ai = 0; ai < 2; ++ai)
#pragma unroll
            for (int m = 0; m < 4; ++m) { const int R = ai * HALF + wr * 64 + m * 16 + fr; const float r = rs[u.slot * 256 + R] * (1.f / W8_SCALE), w = wts[u.slot * 256 + R] * r * H8_SCALE;
                const f32x4 g0 = acc[ai][0][m][0] * r, g1 = acc[ai][0][m][1] * r, u0 = acc[ai][1][m][0] * w, u1 = acc[ai][1][m][1] * w;
                v2u o; o.x = pk4_fp8(g0[0] * sigmoidf_(g0[0]) * u0[0], g0[1] * sigmoidf_(g0[1]) * u0[1], g0[2] * sigmoidf_(g0[2]) * u0[2], g0[3] * sigmoidf_(g0[3]) * u0[3]);
                o.y = pk4_fp8(g1[0] * sigmoidf_(g1[0]) * u1[0], g1[1] * sigmoidf_(g1[1]) * u1[1], g1[2] * sigmoidf_(g1[2]) * u1[2], g1[3] * sigmoidf_(g1[3]) * u1[3]);
                *(v2u*)((unsigned char*)H + (size_t)(u.pm * BM + R) * DFF + cb) = o; }
    }
};
struct EpiYStore {
    static constexpr bool PERM = true;
    bf16* Y;
    __device__ __forceinline__ void operator()(AccRef acc, const Unit& u, int wr, int wc, int fr, int fq) const {
        const int cb = 256 * (u.pn & 7) + 32 * wc + 8 * fq;
#pragma unroll
        for (int ai = 0; ai < 2; ++ai)
#pragma unroll
            for (int m = 0; m < 4; ++m) { const int R = ai * HALF + wr * 64 + m * 16 + fr;
#pragma unroll
                for (int bj = 0; bj < 2; ++bj) { const f32x4 v0 = acc[ai][bj][m][0] * (1.f / (W8_SCALE * H8_SCALE)), v1 = acc[ai][bj][m][1] * (1.f / (W8_SCALE * H8_SCALE));
                    v4u w; w.x = cvt_pk_bf16(v0[0], v0[1]); w.y = cvt_pk_bf16(v0[2], v0[3]); w.z = cvt_pk_bf16(v1[0], v1[1]); w.w = cvt_pk_bf16(v1[2], v1[3]);
                    *(v4u*)(Y + (size_t)(u.pm * BM + R) * DM + cb + 128 * bj) = w; } }
    }
};
struct EpiScatter {
    static constexpr bool PERM = false;
    float* O; const LAS int* toks;
    __device__ __forceinline__ void operator()(AccRef acc, const Unit& u, int wr, int wc, int fr, int fq) const {
        const int col0 = (u.pn & 7) * BM + wc * 32 + 4 * fq;
#pragma unroll
        for (int ai = 0; ai < 2; ++ai)
#pragma unroll
            for (int m = 0; m < 4; ++m) { const int R = ai * HALF + wr * 64 + m * 16 + fr; const int tok = toks[u.slot * 256 + R];
                if (tok >= 0) { float* ro = O + (size_t)tok * DM + col0;
#pragma unroll
                    for (int bj = 0; bj < 2; ++bj)
#pragma unroll
                        for (int n = 0; n < 2; ++n) { const f32x4 v = acc[ai][bj][m][n]; float* p = ro + bj * HALF + n * 16;
                            unsafeAtomicAdd(p + 0, v[0]); unsafeAtomicAdd(p + 1, v[1]); unsafeAtomicAdd(p + 2, v[2]); unsafeAtomicAdd(p + 3, v[3]); } } }
    }
};
}

#define XB_TMO      128
#define XB_XCNT(j)  (256  + 64 * (j))
#define XB_XSUB(j)  (1280 + 64 * (j))
#define XB_XGEN(j)  (2304 + 64 * (j))
#define XB_TOP      3328
#define XB_TOPGEN   3392
#define XCD_BAR_WORDS 3456
#define XB_SPIN_CAP (1u << 18)
__device__ __forceinline__ unsigned xb_ld(unsigned* p)              { return __hip_atomic_load(p, __ATOMIC_RELAXED, __HIP_MEMORY_SCOPE_AGENT); }
__device__ __forceinline__ unsigned xb_add(unsigned* p, unsigned v) { return __hip_atomic_fetch_add(p, v, __ATOMIC_RELAXED, __HIP_MEMORY_SCOPE_AGENT); }
__device__ __forceinline__ unsigned xb_xcc_id() { return (unsigned)__builtin_amdgcn_s_getreg((3 << 11) | 20) & 0xFu; }
#define XB_SPIN(cond, bar) do { unsigned _sp = 0; while (cond) { __builtin_amdgcn_s_sleep(1); \
    if ((++_sp & 255u) == 0u) { if (xb_ld(&(bar)[XB_TMO])) break; if (_sp > XB_SPIN_CAP) { atomicAdd(&(bar)[XB_TMO], 1u); break; } } } } while (0)
struct XcdBarrier { unsigned* bar; unsigned x; volatile LAS unsigned* st; };
__device__ __forceinline__ XcdBarrier xcd_barrier_post(unsigned* bar, volatile LAS unsigned* st, const int tid) {
    XcdBarrier b; b.bar = bar; b.x = xb_xcc_id(); b.st = st;
    if (tid == 0) (void)xb_add(&bar[XB_XCNT(b.x)], 1u);
    return b;
}
__device__ __forceinline__ void xcd_barrier_complete(unsigned* bar, unsigned x, unsigned& nloc, unsigned& nx) {
    const unsigned G = gridDim.x * gridDim.y * gridDim.z;
    unsigned sum, cnt, mine, sp = 0u;
    for (;;) {
        sum = 0u; cnt = 0u; mine = 0u;
#pragma unroll
        for (unsigned j = 0; j < 16; ++j) { const unsigned c = xb_ld(&bar[XB_XCNT(j)]); sum += c; cnt += (c > 0u) ? 1u : 0u; mine = (j == x) ? c : mine; }
        if (sum == G) break;
        __builtin_amdgcn_s_sleep(1);
        if ((++sp & 255u) == 0u) { if (xb_ld(&bar[XB_TMO])) break; if (sp > XB_SPIN_CAP) { atomicAdd(&bar[XB_TMO], 1u); break; } }
    }
    nloc = mine > 0u ? mine : 1u; nx = cnt > 0u ? cnt : 1u;
}
__device__ __forceinline__ void xcd_barrier(const XcdBarrier& b, const int tid) {
    asm volatile("s_waitcnt vmcnt(0)" ::: "memory");
    __syncthreads();
    if (tid == 0) {
        unsigned* bar = b.bar;
        __builtin_amdgcn_s_waitcnt(0);
        unsigned nloc = b.st[0], nx = b.st[1];
        if (nloc == 0u) { xcd_barrier_complete(bar, b.x, nloc, nx); b.st[0] = nloc; b.st[1] = nx; }
        const unsigned old = xb_add(&bar[XB_XSUB(b.x)], 1u);
        const unsigned gen = old / nloc;
        if (old + 1u == (gen + 1u) * nloc) {
            __builtin_amdgcn_fence(__ATOMIC_RELEASE, "agent");
            asm volatile("s_waitcnt vmcnt(0)" ::: "memory");
            const unsigned og = xb_add(&bar[XB_TOP], 1u);
            const unsigned tg = og / nx;
            if (og + 1u == (tg + 1u) * nx) xb_add(&bar[XB_TOPGEN], 1u);
            else XB_SPIN(xb_ld(&bar[XB_TOPGEN]) == tg, bar);
            __builtin_amdgcn_fence(__ATOMIC_ACQUIRE, "agent");
            xb_add(&bar[XB_XGEN(b.x)], 1u);
            asm volatile("s_waitcnt vmcnt(0)" ::: "memory");
        } else {
            XB_SPIN(xb_ld(&bar[XB_XGEN(b.x)]) == gen, bar);
            __builtin_amdgcn_fence(__ATOMIC_ACQUIRE, "agent");
            asm volatile("s_waitcnt vmcnt(0)" ::: "memory");
        }
    }
    __syncthreads();
}

struct Args {
    const float *x, *norm1_g, *w_in, *q_norm_g, *k_norm_g, *conv_w, *conv_b, *conv_ln_g, *conv_ln_b, *rel_bias, *w_out, *norm2_g, *w_rg, *b_rg, *w_re, *b_re, *w_gate, *w_up, *w_down;
    float* out; float* out_w; unsigned char* ws; int ph_lo, ph_hi;
};

__device__ __forceinline__ void transpose_item(const float* Wsrc, int ldw, bf16* dst, int ldd, LAS float* scr, int lane) {
    const float* p = Wsrc + (size_t)(lane >> 5) * ldw + (lane & 31);
#pragma unroll 1
    for (int hh = 0; hh < 2; ++hh) {
        float tv[16];
#pragma unroll
        for (int i = 0; i < 16; ++i) { tv[i] = *p; p += 2 * ldw; }
#pragma unroll
        for (int i = 0; i < 16; ++i) { const int kk = 2 * (16 * hh + i) + (lane >> 5); scr[kk * 33 + (lane & 31)] = tv[i]; }
    }
    LDS_WAIT(); asm volatile("" ::: "memory");
    const int c = lane & 7;
#pragma unroll
    for (int j = 0; j < 4; ++j) { const int n = (lane >> 3) + 8 * j; const LAS float* s = scr + (8 * c) * 33 + n;
        v4u o; o.x = pk2(s[0 * 33], s[1 * 33]); o.y = pk2(s[2 * 33], s[3 * 33]); o.z = pk2(s[4 * 33], s[5 * 33]); o.w = pk2(s[6 * 33], s[7 * 33]);
        *(GAS v4u*)(dst + (size_t)n * ldd + 8 * c) = o; }
    LDS_WAIT(); asm volatile("" ::: "memory");
}
__device__ __forceinline__ void t64_load(const float* Wsrc, int ldw, int lane, f32x4 (&tv)[16]) {
    const float* p = Wsrc + (size_t)(lane >> 3) * ldw + 4 * (lane & 7);
#pragma unroll
    for (int i = 0; i < 16; ++i) { tv[i] = __builtin_nontemporal_load((const f32x4*)p); p += 8 * ldw; }
}
__device__ __forceinline__ void t64_finish(const f32x4 (&tv)[16], unsigned char* dst, int ldd, int f8, LAS unsigned char* scr, int lane) {
    const int g = lane >> 4, i16 = lane & 15;
#pragma unroll
    for (int i = 0; i < 16; ++i) { v2u w; w.x = cvt_pk_bf16(tv[i].x, tv[i].y); w.y = cvt_pk_bf16(tv[i].z, tv[i].w); *(LAS v2u*)(scr + (8 * i + (lane >> 3)) * 64 + 8 * (lane & 7)) = w; }
    LDS_WAIT(); asm volatile("" ::: "memory");
    const int q = i16 >> 2, pp = i16 & 3;
    bf16x8 o[8];
#pragma unroll
    for (int jj = 0; jj < 8; ++jj) { const int c = 4 * jj + g, nb = c & 1, kg = c >> 1;
        LAS unsigned char* ra = scr + (8 * kg + q) * 64 + 32 * nb + 8 * pp;
        const s16x4 lo = __builtin_bit_cast(s16x4, __builtin_amdgcn_ds_read_tr16_b64_v4i16((LAS s16x4*)ra));
        const s16x4 hi = __builtin_bit_cast(s16x4, __builtin_amdgcn_ds_read_tr16_b64_v4i16((LAS s16x4*)(ra + 4 * 64)));
        o[jj] = __builtin_shufflevector(lo, hi, 0, 1, 2, 3, 4, 5, 6, 7); }
    LDS_WAIT(); asm volatile("" ::: "memory");
#pragma unroll
    for (int jj = 0; jj < 8; ++jj) { const int c = 4 * jj + g, nb = c & 1, kg = c >> 1; const int n = 16 * nb + i16;
        *(LAS bf16x8*)(scr + n * 256 + 16 * (kg ^ (n & 15))) = o[jj]; }
    LDS_WAIT(); asm volatile("" ::: "memory");
    const int rr = lane >> 3, cc = lane & 7;
#pragma unroll
    for (int it = 0; it < 4; ++it) { const int n = 8 * it + rr;
        const v4u v0 = *(const LAS v4u*)(scr + n * 256 + 16 * ((2 * cc) ^ (n & 15))), v1 = *(const LAS v4u*)(scr + n * 256 + 16 * ((2 * cc + 1) ^ (n & 15)));
        if (f8) { v4u o4; o4.x = pk4_fp8(bf_lo(v0.x) * W8_SCALE, bf_hi(v0.x) * W8_SCALE, bf_lo(v0.y) * W8_SCALE, bf_hi(v0.y) * W8_SCALE);
            o4.y = pk4_fp8(bf_lo(v0.z) * W8_SCALE, bf_hi(v0.z) * W8_SCALE, bf_lo(v0.w) * W8_SCALE, bf_hi(v0.w) * W8_SCALE);
            o4.z = pk4_fp8(bf_lo(v1.x) * W8_SCALE, bf_hi(v1.x) * W8_SCALE, bf_lo(v1.y) * W8_SCALE, bf_hi(v1.y) * W8_SCALE);
            o4.w = pk4_fp8(bf_lo(v1.z) * W8_SCALE, bf_hi(v1.z) * W8_SCALE, bf_lo(v1.w) * W8_SCALE, bf_hi(v1.w) * W8_SCALE);
            __builtin_nontemporal_store(o4, (GAS v4u*)(dst + (size_t)n * ldd + 16 * cc)); }
        else { *(GAS v4u*)(dst + (size_t)n * ldd + 32 * cc) = v0; *(GAS v4u*)(dst + (size_t)n * ldd + 32 * cc + 16) = v1; } }
    LDS_WAIT(); asm volatile("" ::: "memory");
}
__device__ __forceinline__ int win_src_col(int n0) {
    const int pn = n0 >> 8, j = n0 & 255;
    if (pn < 8) return ((j >> 7) ? CCH : 0) + 128 * pn + (j & 127);
    if (pn < 16) { const int t = pn - 8, tensor = t >> 2, head = 4 * (t & 3) + ((j >> 5) & 3), dim = 32 * (j >> 7); return 2 * CCH + AW * tensor + 64 * head + dim; }
    return 2 * CCH + 2 * AW + 256 * (pn - 16) + j;
}
__device__ __forceinline__ void rms_row_to_bf16(const float* xrow, const float* g, bf16* orow, int lane) {
    const GAS f32x4* xr = (const GAS f32x4*)xrow + lane; const GAS f32x4* gr = (const GAS f32x4*)g + lane;
    f32x4 v[8]; float s = 0.f;
#pragma unroll
    for (int j = 0; j < 8; ++j) { v[j] = xr[64 * j]; s += (v[j].x * v[j].x + v[j].y * v[j].y) + (v[j].z * v[j].z + v[j].w * v[j].w); }
    const float rstd = __builtin_amdgcn_rsqf(wave_sum(s) * (1.f / DM) + NORM_EPS);
    GAS v2u* o8 = (GAS v2u*)orow + lane;
#pragma unroll
    for (int j = 0; j < 8; ++j) { const f32x4 gg = gr[64 * j]; v2u w; w.x = pk2(v[j].x * rstd * gg.x, v[j].y * rstd * gg.y); w.y = pk2(v[j].z * rstd * gg.z, v[j].w * rstd * gg.w); o8[64 * j] = w; }
}

template <int P, int NT>
__device__ __forceinline__ void attn_pattern(const bf16* __restrict__ Kh, const bf16* __restrict__ Vh, const int t0, LAS unsigned char* vbuf, const LAS float* bt,
                                             const bf16x8 (&qf)[NT][2], f32x4 (&o)[NT][4], f32x4 (&lacc)[NT], int lane) {
    constexpr int DL = (P == 0) ? 1 : (P == 1) ? 4 : 16, SQ = 16 / DL, GS = 3, NGRPS = (P == 0) ? 4 : 2;
    constexpr int SH = 8 / DL;
    static_assert(NT == 1 || P < 2, "tile pairs share keys only for dilation 1 and 4");
    const int qi = lane & 15, g = lane >> 4, q4 = qi >> 2, pp = qi & 3;
    const int xr = (2 * g + (q4 >> 1)) & 3;
    unsigned tra[4];
#pragma unroll
    for (int dt = 0; dt < 4; ++dt) tra[dt] = (unsigned)((4 * g + q4) * 128 + 32 * (dt ^ xr) + 8 * pp);
    unsigned klo[2], vlo[4], vwa[4];
#pragma unroll
    for (int tt = 0; tt < 2; ++tt) klo[tt] = (unsigned)(DL * (16 * tt + qi) * AW + 8 * g);
#pragma unroll
    for (int k = 0; k < 4; ++k) { const int idx = lane + 64 * k, row = idx >> 3, c16 = idx & 7; vlo[k] = (unsigned)(DL * row * AW + 8 * c16); vwa[k] = (unsigned)(row * 128 + 16 * (c16 ^ (((row >> 1) & 3) << 1))); }
    const int tq = t0 / DL;
    unsigned relmax[NT];
#pragma unroll
    for (int x = 0; x < NT; ++x) { const int m = SQ * qi + tq + x * SH; relmax[x] = (unsigned)(m < 128 ? m : 128); }
    const int relb = 128 + SQ * qi - 4 * g;
    const bf16x8 ones = (bf16x8){0x3f80, 0x3f80, 0x3f80, 0x3f80, 0x3f80, 0x3f80, 0x3f80, 0x3f80};
#pragma unroll 1
    for (int grp = 0; grp < NGRPS; ++grp) {
        bf16x8 kfg[GS][2][2]; v4u vrg[GS][4];
#pragma unroll
        for (int s3 = 0; s3 < GS; ++s3) { if (P == 2 && GS * grp + s3 >= 5) break;
            const long ro = ((long)t0 + DL * (32 * (GS * grp + s3) - 128)) * AW; const bf16* kb = Kh + ro; const bf16* vbs = Vh + ro;
#pragma unroll
            for (int tt = 0; tt < 2; ++tt) { kfg[s3][tt][0] = *(const bf16x8*)(kb + klo[tt]); kfg[s3][tt][1] = *(const bf16x8*)(kb + klo[tt] + 32); }
#pragma unroll
            for (int k = 0; k < 4; ++k) vrg[s3][k] = *(const v4u*)(vbs + vlo[k]); }
#pragma unroll
        for (int s3 = 0; s3 < GS; ++s3) {
            const int c = GS * grp + s3;
            if (P == 2 && c >= 5) break;
            LAS unsigned char* vb = vbuf + s3 * 4096;
#pragma unroll
            for (int k = 0; k < 4; ++k) *(LAS v4u*)(vb + vwa[k]) = vrg[s3][k];
            const int rel0 = relb - 32 * c;
            bf16x8 pf[NT];
#pragma unroll
            for (int x = 0; x < NT; ++x) {
                f32x4 sc[2];
#pragma unroll
                for (int tt = 0; tt < 2; ++tt) { f32x4 z = (f32x4){0.f, 0.f, 0.f, 0.f};
                    z = __builtin_amdgcn_mfma_f32_16x16x32_bf16(kfg[s3][tt][0], qf[x][0], z, 0, 0, 0);
                    sc[tt] = __builtin_amdgcn_mfma_f32_16x16x32_bf16(kfg[s3][tt][1], qf[x][1], z, 0, 0, 0); }
                const LAS float* btp = bt + (rel0 + x * SH - 19);
                float p[2][4];
#pragma unroll
                for (int tt = 0; tt < 2; ++tt)
#pragma unroll
                    for (int e = 0; e < 4; ++e) { const int rel = rel0 + x * SH - 16 * tt - e;
                        const float pe = __builtin_amdgcn_exp2f(sc[tt][e] + btp[19 - 16 * tt - e]);
                        p[tt][e] = ((unsigned)rel <= relmax[x]) ? pe : 0.f; }
                v4u pw; pw.x = cvt_pk_s(p[0][0], p[0][1]); pw.y = cvt_pk_s(p[0][2], p[0][3]); pw.z = cvt_pk_s(p[1][0], p[1][1]); pw.w = cvt_pk_s(p[1][2], p[1][3]);
                pf[x] = __builtin_bit_cast(bf16x8, pw);
                lacc[x] = __builtin_amdgcn_mfma_f32_16x16x32_bf16(ones, pf[x], lacc[x], 0, 0, 0);
            }
#pragma unroll
            for (int dt = 0; dt < 4; ++dt) {
                const s16x4 lo = __builtin_bit_cast(s16x4, __builtin_amdgcn_ds_read_tr16_b64_v4i16((LAS s16x4*)(vb + tra[dt])));
                const s16x4 hi = __builtin_bit_cast(s16x4, __builtin_amdgcn_ds_read_tr16_b64_v4i16((LAS s16x4*)(vb + tra[dt] + 2048)));
                const bf16x8 vf = __builtin_shufflevector(lo, hi, 0, 1, 2, 3, 4, 5, 6, 7);
#pragma unroll
                for (int x = 0; x < NT; ++x) o[x][dt] = __builtin_amdgcn_mfma_f32_16x16x32_bf16(vf, pf[x], o[x][dt], 0, 0, 0);
            }
        }
    }
}

__device__ __forceinline__ void attn_wave(const bf16* Q, const bf16* Kb, const bf16* Vb, bf16* MIX, int h, const int t0, LAS unsigned char* vbuf, const LAS float* bt, int lane) {
    asm volatile("" : "+v"(lane));
    const int qi = lane & 15, g = lane >> 4;
    bf16x8 qf[2][2]; f32x4 o[2][4]; f32x4 lacc[2];
#pragma unroll
    for (int x = 0; x < 2; ++x) { const bf16* qrow = Q + (size_t)(t0 + 8 * x + 16 * qi) * AW + 64 * h + 8 * g; qf[x][0] = *(const bf16x8*)qrow; qf[x][1] = *(const bf16x8*)(qrow + 32);
        lacc[x] = (f32x4){0.f, 0.f, 0.f, 0.f};
#pragma unroll
        for (int dt = 0; dt < 4; ++dt) o[x][dt] = (f32x4){0.f, 0.f, 0.f, 0.f}; }
    const bf16* Kh = Kb + 64 * h; const bf16* Vh = Vb + 64 * h;
    attn_pattern<0, 2>(Kh, Vh, t0, vbuf, bt, qf, o, lacc, lane);
    attn_pattern<1, 2>(Kh, Vh, t0, vbuf, bt + 132, qf, o, lacc, lane);
#pragma unroll
    for (int x = 0; x < 2; ++x) {
        bf16x8 q1[1][2] = {{qf[x][0], qf[x][1]}}; f32x4 o1[1][4] = {{o[x][0], o[x][1], o[x][2], o[x][3]}}; f32x4 l1[1] = {lacc[x]};
        attn_pattern<2, 1>(Kh, Vh, t0 + 8 * x, vbuf, bt + 264, q1, o1, l1, lane);
        const float inv = 1.f / l1[0][0];
        bf16* orow = MIX + (size_t)(t0 + 8 * x + 16 * qi) * DM + CCH + 64 * h + 4 * g;
#pragma unroll
        for (int dt = 0; dt < 4; ++dt) { v2u w; w.x = cvt_pk_bf16(o1[0][dt][0] * inv, o1[0][dt][1] * inv); w.y = cvt_pk_bf16(o1[0][dt][2] * inv, o1[0][dt][3] * inv); *(v2u*)(orow + 16 * dt) = w; }
    }
}

constexpr int CV_IN = (DM / 64) * (INW / 32), CV_OUT = (DM / 64) * (DM / 32), CV_GU = NEXP * 2 * (DM / 128) * (DFF / 32), CV_D = NEXP * (DFF / 128) * (DM / 32);
constexpr int CV_SMALL = CV_IN + CV_OUT, CV_ALL = CV_SMALL + CV_GU + CV_D;
constexpr int P1_ROUNDS = 4;
constexpr int CV_N1 = 28672, CV_N5 = 6144;
__device__ __forceinline__ void convert_item(const float* w_in, const float* w_out, int r, bf16* BTIN, bf16* BTOUT, LAS float* scr, int lane) {
    if (r < CV_IN) { const int nblk = INW / 32, kb = r / nblk, nb = r % nblk; transpose_item(w_in + (size_t)(64 * kb) * INW + win_src_col(32 * nb), INW, BTIN + (size_t)(32 * nb) * DM + 64 * kb, DM, scr, lane); return; }
    r -= CV_IN;
    { const int nblk = DM / 32, kb = r / nblk, nb = r % nblk; transpose_item(w_out + (size_t)(64 * kb) * DM + 32 * nb, DM, BTOUT + (size_t)(32 * nb) * DM + 64 * kb, DM, scr, lane); }
}
struct XItem { const float* src; unsigned char* dst; int ldw, ldd, f8; };
__device__ __forceinline__ XItem xitem(const float* w_gate, const float* w_up, const float* w_down, bf16* BTGU, bf16* BTD, int r) {
    XItem it;
    if (r < CV_GU) { const int per = (DM / 128) * (DFF / 32); const int e = r / (2 * per), r2 = r % (2 * per), which = r2 / per, r3 = r2 % per; const int nblk = DFF / 32, kb = r3 / nblk, nb = r3 % nblk;
        const float* W = (which ? w_up : w_gate) + (size_t)e * DM * DFF;
        const int f0 = 32 * nb, brow = 256 * (f0 >> 7) + 128 * which + (f0 & 127);
        it.src = W + (size_t)(128 * kb) * DFF + f0; it.ldw = DFF; it.dst = (unsigned char*)BTGU + ((size_t)e * 2048 + brow) * DM + 128 * kb; it.ldd = DM; it.f8 = 1; return it; }
    r -= CV_GU;
    { const int per = (DFF / 128) * (DM / 32); const int e = r / per, r3 = r % per; const int nblk = DM / 32, kb = r3 / nblk, nb = r3 % nblk;
        it.src = w_down + (size_t)e * DFF * DM + (size_t)(128 * kb) * DM + 32 * nb; it.ldw = DM; it.dst = (unsigned char*)BTD + ((size_t)e * DM + 32 * nb) * DFF + 128 * kb; it.ldd = DFF; it.f8 = 1; return it; }
}
__device__ __forceinline__ void convert_range(const float* w_gate, const float* w_up, const float* w_down, bf16* BTGU, bf16* BTD, int x0, int x1, LAS unsigned char* scr, int lane) {
    if (x0 >= x1) return;
    f32x4 ta[16], tc[16];
    XItem A = xitem(w_gate, w_up, w_down, BTGU, BTD, x0), B = A;
    t64_load(A.src, A.ldw, lane, ta);
#pragma unroll 1
    for (int x = x0; x < x1; x += 2) {
        const bool hasB = x + 1 < x1;
        if (hasB) { B = xitem(w_gate, w_up, w_down, BTGU, BTD, x + 1); t64_load(B.src, B.ldw, lane, tc); }
        t64_finish(ta, A.dst, A.ldd, A.f8, scr, lane);
        if (hasB) {
            if (x + 2 < x1) { A = xitem(w_gate, w_up, w_down, BTGU, BTD, x + 2); t64_load(A.src, A.ldw, lane, ta); }
            t64_finish(tc, B.dst, B.ldd, B.f8, scr, lane);
        }
    }
}

__global__ void __launch_bounds__(512, 2) hymba_fwd(Args args) {
    extern __shared__ __attribute__((aligned(16))) unsigned char lds_raw[];
    LAS unsigned char* lds = (LAS unsigned char*)lds_raw;
    const int wave = __builtin_amdgcn_readfirstlane(threadIdx.x >> 6);
#define TID() (wave * 64 + lane_id_v())
    const int G = gridDim.x, bx = blockIdx.x;
    unsigned char* ws = args.ws;
    gu32* ctl = (gu32*)(ws + WS_CTL);
    int* ltok = (int*)(ws + WS_LTOK); float* lw = (float*)(ws + WS_LW);
    bf16* BTIN = (bf16*)(ws + WS_BTIN); bf16* BTOUT = (bf16*)(ws + WS_BTOUT); bf16* XN = (bf16*)(ws + WS_XN); bf16* Ub = (bf16*)(ws + WS_U);
    bf16* X1B = (bf16*)(ws + WS_Q);
    bf16* Qb = (bf16*)(ws + WS_Q); bf16* Kb = (bf16*)(ws + WS_K); bf16* Vb = (bf16*)(ws + WS_V); bf16* MIX = (bf16*)(ws + WS_MIX); bf16* Hb = (bf16*)(ws + WS_H);
    bf16* BTGU = (bf16*)(ws + WS_BTGU); bf16* BTD = (bf16*)(ws + WS_BTD); bf16* Yb = (bf16*)(ws + WS_Y);
    volatile LAS unsigned* MISC = (volatile LAS unsigned*)(lds + MISC_OFF);
    { const int tid = TID(); if (tid < 16) MISC[tid] = 0u; }
    __syncthreads();
    XcdBarrier bar; bar.bar = (unsigned*)(ctl + CW_BAR); bar.x = 0; bar.st = nullptr;
    if (N_LAUNCHES == 1) bar = xcd_barrier_post((unsigned*)(ctl + CW_BAR), MISC, TID());
    const int lo = args.ph_lo, hi = args.ph_hi;
#define IN(k) (lo <= (k) && (k) < hi)
#define BOTH(k) (IN(k) && IN((k) + 1))
#define GRID_BAR() xcd_barrier(bar, TID())
    const int gw = bx * 8 + wave, NGW = G * 8;

    if (IN(0)) {
        const int lane = lane_id_v();
        LAS float* scr = (LAS float*)(lds + wave * 16384);
        for (int it = gw; it < CV_SMALL; it += NGW) convert_item(args.w_in, args.w_out, it, BTIN, BTOUT, scr, lane);
        for (int m = gw; m < SEQ; m += NGW) rms_row_to_bf16(args.x + (size_t)m * DM, args.norm1_g, XN + (size_t)m * DM, lane);
        {
            bf16* WRH = (bf16*)(ws + WS_WRH); bf16* WRL = (bf16*)(ws + WS_WRL);
            for (int idx = gw * 64 + lane; idx < 48 * DM; idx += NGW * 64) { const int j = idx / DM, d = idx % DM;
                float w = 0.f;
                if (j < 4) w = args.w_rg[d * NGRP + j]; else if (j < 36) w = args.w_re[((size_t)((j - 4) >> 3) * DM + d) * EPG + ((j - 4) & 7)];
                w *= args.norm2_g[d];
                const unsigned hi = f2bf(w); const float rem = w - __builtin_bit_cast(float, hi << 16);
                WRH[idx] = (bf16)hi; WRL[idx] = (bf16)f2bf(rem); }
        }
        if (BOTH(0)) GRID_BAR();
    }

    if (IN(1)) {
        const int units = (SEQ / 256) * (INW / 256), GG = (G >= 256) ? (units + P1_ROUNDS - 1) / P1_ROUNDS : G, FB = G - GG;
        if (bx < GG) {
            pg8::Gemm g{XN, BTIN, DM}; pg8::StaticOrder S; S.init(SEQ, INW, GG, bx);
            pg8::EpiInProj E{Ub, Qb, Kb, Vb, args.q_norm_g, args.k_norm_g};
            pg8::gemm_phase<pg8::EpiInProj, pg8::StaticOrder, true, false>(lds, g, S, E, nullptr, TID());
        }
        {   const int lane = lane_id_v();
            const int nb = FB > 0 ? FB : G, ti = FB > 0 ? bx - GG : bx;
            if (ti >= 0) { const int q = (CV_N1 + nb * 8 - 1) / (nb * 8), x0 = (ti * 8 + wave) * q, x1 = (x0 + q < CV_N1) ? x0 + q : CV_N1;
                convert_range(args.w_gate, args.w_up, args.w_down, BTGU, BTD, x0, x1, lds + wave * 8448, lane); }
        }
        if (BOTH(1)) GRID_BAR();
    }

    if (IN(2)) {
        LAS float* btab = (LAS float*)(lds + 8 * 12288);
        const int tid = TID(), lane = tid & 63;
        {
            float mq = 0.f, mk = 0.f;
            for (int d = 0; d < HD; ++d) { mq = fmaxf(mq, fabsf(args.q_norm_g[d])); mk = fmaxf(mk, fabsf(args.k_norm_g[d])); }
            for (int idx = tid; idx < NH * 3 * 132; idx += 512) { const int h = idx / 396, r2 = idx % 396, p = r2 / 132, rel = r2 % 132;
                float mb = 0.f; for (int b = 0; b < 32; ++b) mb = fmaxf(mb, fabsf(args.rel_bias[b * NH + h]));
                const float Mh = 1.02f * C2 * 64.f * mq * mk + mb * LOG2E;
                btab[idx] = args.rel_bias[(int)kBucket[p][rel] * NH + h] * LOG2E - Mh; }
        }
        __syncthreads();
        LAS unsigned char* vbuf = lds + wave * 12288;
        {
            constexpr int CV_LO = CV_N1, CV_HI = CV_GU + CV_D - CV_N5, CV_EXP = CV_HI - CV_LO;
            const int nA = (512 - bx + G - 1) / G;
            const int per_wave = (CV_EXP + NGW - 1) / NGW;
            const int c_lo = CV_LO + gw * per_wave, c_hi = (c_lo + per_wave < CV_HI) ? c_lo + per_wave : CV_HI;
            const int nsteps = nA > 0 ? nA : 1, per_batch = (per_wave + nsteps - 1) / nsteps;
            int ia = 0, ic = c_lo;
#pragma unroll 1
            for (int hs = 0; hs < 2 * nsteps; ++hs) {
                const bool doA = (((hs & 1) == 0) == (wave < 4));
                if (doA) { if (ia < nA) { const int a = bx + ia * G; const int blk = a >> 4, h = a & 15;
                        attn_wave(Qb, Kb, Vb, MIX, h, 256 * blk + wave, vbuf, btab + h * 396, lane); ++ia; } }
                else { const int ce = (ic + per_batch < c_hi) ? ic + per_batch : c_hi;
                    convert_range(args.w_gate, args.w_up, args.w_down, BTGU, BTD, ic, ce, vbuf, lane); ic = ce > ic ? ce : ic; }
            }
            convert_range(args.w_gate, args.w_up, args.w_down, BTGU, BTD, ic, c_hi, vbuf, lane);
        }
        __syncthreads();
        LAS float* cv = (LAS float*)lds;
        for (int ct = bx; ct < SEQ / 32; ct += G) {
            const int tb0 = 32 * ct, c0 = 2 * tid;
            float w0[CONVW], w1[CONVW];
#pragma unroll
            for (int j = 0; j < CONVW; ++j) { const f32x2 w = *(const f32x2*)(args.conv_w + j * CCH + c0); w0[j] = w.x; w1[j] = w.y; }
            const f32x2 cb = *(const f32x2*)(args.conv_b + c0);
            unsigned uw[62];
#pragma unroll
            for (int i = 0; i < 62; ++i) { const int tr = tb0 - 30 + i; uw[i] = (tr >= 0) ? *(const unsigned*)(Ub + (size_t)tr * CCH + c0) : 0u; }
#pragma unroll
            for (int i = 0; i < 32; ++i) { float a0 = cb.x, a1 = cb.y;
#pragma unroll
                for (int j = 0; j < CONVW; ++j) { a0 += w0[j] * bf_lo(uw[i + j]); a1 += w1[j] * bf_hi(uw[i + j]); }
                *(LAS f32x2*)(cv + i * CCH + c0) = (f32x2){a0, a1}; }
            __syncthreads();
#pragma unroll 1
            for (int i = wave; i < 32; i += 8) {
                f32x4 v[4]; float s = 0.f;
#pragma unroll
                for (int k = 0; k < 4; ++k) { v[k] = *(const LAS f32x4*)(cv + i * CCH + 4 * lane + 256 * k); s += (v[k].x + v[k].y) + (v[k].z + v[k].w); }
                const float mean = wave_sum(s) * (1.f / CCH); float s2 = 0.f;
#pragma unroll
                for (int k = 0; k < 4; ++k) { v[k] = v[k] - mean; s2 += (v[k].x * v[k].x + v[k].y * v[k].y) + (v[k].z * v[k].z + v[k].w * v[k].w); }
                const float rstd = __builtin_amdgcn_rsqf(wave_sum(s2) * (1.f / CCH) + NORM_EPS);
                bf16* orow = MIX + (size_t)(tb0 + i) * DM;
#pragma unroll
                for (int k = 0; k < 4; ++k) { const int c = 4 * lane + 256 * k; const f32x4 gg = *(const f32x4*)(args.conv_ln_g + c), bb = *(const f32x4*)(args.conv_ln_b + c);
                    f32x4 y = v[k] * rstd * gg + bb; y.x *= sigmoidf_(y.x); y.y *= sigmoidf_(y.y); y.z *= sigmoidf_(y.z); y.w *= sigmoidf_(y.w);
                    v2u w; w.x = pk2(y.x, y.y); w.y = pk2(y.z, y.w); *(v2u*)(orow + c) = w; }
            }
            __syncthreads();
        }
        if (BOTH(2)) GRID_BAR();
    }

    if (IN(3)) {
        pg8::Gemm g{MIX, BTOUT, DM}; pg8::StaticOrder S; S.init(SEQ, DM, G, bx);
        pg8::EpiResF32 E{args.x, X1B, XN, args.norm2_g};
        pg8::gemm_phase<pg8::EpiResF32, pg8::StaticOrder, true, false>(lds, g, S, E, nullptr, TID());
        if (BOTH(3)) GRID_BAR();
    }

    if (IN(4)) {
        const int tid = TID(), lane = tid & 63, li = lane & 15, kg = lane >> 4;
        LAS float* part = (LAS float*)lds;
        LAS float* logit = (LAS float*)(lds + 49152);
        LAS float* ssp = (LAS float*)(lds + 49152 + 6144);
        LAS float* rsl = ssp + 256;
        LAS int* selE = (LAS int*)(rsl + 32); LAS float* selW = (LAS float*)(selE + 64);
        int* tokpos = (int*)(ws + WS_TOKPOS); float* rstd_g = (float*)(ws + WS_RSTD);
        const bf16* WRH = (const bf16*)(ws + WS_WRH); const bf16* WRL = (const bf16*)(ws + WS_WRL);
        constexpr int NTILE = SEQ / 32;
        for (int tile = bx; tile < NTILE; tile += G) {
            const int t0 = 32 * tile;
            {
                const bf16* xp = X1B + (size_t)(t0 + li) * DM + 256 * wave + 8 * kg;
                const bf16* hp = WRH + (size_t)li * DM + 256 * wave + 8 * kg; const bf16* lp = WRL + (size_t)li * DM + 256 * wave + 8 * kg;
                f32x4 acc[2][3]; float ss[2] = {0.f, 0.f};
#pragma unroll
                for (int x = 0; x < 2; ++x)
#pragma unroll
                    for (int nt = 0; nt < 3; ++nt) acc[x][nt] = (f32x4){0.f, 0.f, 0.f, 0.f};
#pragma unroll 1
                for (int hf = 0; hf < 2; ++hf) {
                    v4u xa[2][4]; bf16x8 bh[4][3], bl[4][3];
#pragma unroll
                    for (int s4 = 0; s4 < 4; ++s4) { const int ko = 32 * (4 * hf + s4);
#pragma unroll
                        for (int x = 0; x < 2; ++x) xa[x][s4] = *(const v4u*)(xp + (size_t)(16 * x) * DM + ko);
#pragma unroll
                        for (int nt = 0; nt < 3; ++nt) { bh[s4][nt] = *(const bf16x8*)(hp + (size_t)(16 * nt) * DM + ko); bl[s4][nt] = *(const bf16x8*)(lp + (size_t)(16 * nt) * DM + ko); } }
                    asm volatile("s_waitcnt vmcnt(0)" ::: "memory"); __builtin_amdgcn_sched_barrier(0);
#pragma unroll
                    for (int s4 = 0; s4 < 4; ++s4)
#pragma unroll
                        for (int x = 0; x < 2; ++x) { const v4u q = xa[x][s4];
                            ss[x] += (bf_lo(q.x) * bf_lo(q.x) + bf_hi(q.x) * bf_hi(q.x)) + (bf_lo(q.y) * bf_lo(q.y) + bf_hi(q.y) * bf_hi(q.y)) + (bf_lo(q.z) * bf_lo(q.z) + bf_hi(q.z) * bf_hi(q.z)) + (bf_lo(q.w) * bf_lo(q.w) + bf_hi(q.w) * bf_hi(q.w)); }
                    __builtin_amdgcn_sched_barrier(0);
#pragma unroll
                    for (int s4 = 0; s4 < 4; ++s4)
#pragma unroll
                        for (int x = 0; x < 2; ++x) { const bf16x8 xh = __builtin_bit_cast(bf16x8, xa[x][s4]);
#pragma unroll
                            for (int nt = 0; nt < 3; ++nt) {
                                acc[x][nt] = __builtin_amdgcn_mfma_f32_16x16x32_bf16(xh, bl[s4][nt], acc[x][nt], 0, 0, 0);
                                acc[x][nt] = __builtin_amdgcn_mfma_f32_16x16x32_bf16(xh, bh[s4][nt], acc[x][nt], 0, 0, 0); } }
                }
#pragma unroll
                for (int x = 0; x < 2; ++x) {
#pragma unroll
                    for (int nt = 0; nt < 3; ++nt)
#pragma unroll
                        for (int e = 0; e < 4; ++e) part[(wave * 32 + 16 * x + 4 * kg + e) * 48 + 16 * nt + li] = acc[x][nt][e];
                    float s1 = ss[x]; s1 += __shfl_xor(s1, 16); s1 += __shfl_xor(s1, 32);
                    if (kg == 0) ssp[wave * 32 + 16 * x + li] = s1; }
            }
            __syncthreads();
            for (int idx = tid; idx < 32 * 48; idx += 512) { float a = 0.f;
#pragma unroll
                for (int w8 = 0; w8 < 8; ++w8) a += part[w8 * 1536 + idx];
                logit[idx] = a; }
            if (tid < 32) { float a = 0.f;
#pragma unroll
                for (int w8 = 0; w8 < 8; ++w8) a += ssp[w8 * 32 + tid];
                const float r = __builtin_amdgcn_rsqf(a * (1.f / DM) + NORM_EPS); rsl[tid] = r; rstd_g[t0 + tid] = r; }
            __syncthreads();
            if (tid < 32) {
                const float rstd = rsl[tid]; const LAS float* lg = logit + tid * 48;
                int gidx = 0; float gmax = lg[0] * rstd + args.b_rg[0]; float glv[4]; glv[0] = gmax;
#pragma unroll
                for (int k = 1; k < 4; ++k) { glv[k] = lg[k] * rstd + args.b_rg[k]; if (glv[k] > gmax) { gmax = glv[k]; gidx = k; } }
                float gden = 0.f;
#pragma unroll
                for (int k = 0; k < 4; ++k) gden += __expf(glv[k] - gmax);
                const float gwt = 1.f / gden;
                int i0 = 0, i1 = -1; float v0 = -3.0e38f, v1 = -3.0e38f;
                for (int k = 0; k < 8; ++k) { const float v = lg[4 + 8 * gidx + k] * rstd + args.b_re[gidx * EPG + k];
                    if (v > v0) { v1 = v0; i1 = i0; v0 = v; i0 = k; } else if (v > v1) { v1 = v; i1 = k; } }
                const float p0 = 1.f / (1.f + __expf(v1 - v0)), p1 = 1.f - p0;
                selE[2 * tid] = gidx * EPG + i0; selE[2 * tid + 1] = gidx * EPG + i1; selW[2 * tid] = gwt * p0; selW[2 * tid + 1] = gwt * p1;
            }
            __syncthreads();
            if (wave == 0 && lane < NEXP) {
                const int e = lane; int cnt = 0;
                for (int i = 0; i < 64; ++i) cnt += (selE[i] == e) ? 1 : 0;
                unsigned base = 0u;
                if (cnt) base = __hip_atomic_fetch_add((unsigned*)(ctl + CW_CNT + 64 * e), (unsigned)cnt, RLX_AGENT);
                for (int i = 0; i < 64; ++i) if (selE[i] == e) { const int t = t0 + (i >> 1); ltok[e * SEQ + base] = t; lw[e * SEQ + base] = selW[i]; tokpos[2 * t + (i & 1)] = (e << 16) | (int)base; ++base; }
            }
            __syncthreads();
        }
        if (BOTH(4)) GRID_BAR();
    }

    if (IN(5) || IN(6) || IN(7)) {
        LAS int* mtok = (LAS int*)(lds + MOE_TOK_OFF); LAS float* mw = (LAS float*)(lds + MOE_W_OFF); LAS float* mr = (LAS float*)(lds + MOE_R_OFF); LAS int* tb = (LAS int*)(lds + MOE_TB_OFF);
        pg8::MoeOrder S{tb, G, bx};
        { const int tid = TID();
        if (tid == 0) { int acc = 0; for (int e = 0; e < NEXP; ++e) { const int c = (int)__hip_atomic_load((unsigned*)(ctl + CW_CNT + 64 * e), RLX_AGENT); tb[e] = acc; tb[33 + e] = c; acc += (c + 255) >> 8; } tb[32] = acc;
            int ok = (G == 256) ? 1 : 0, F = 0, rank = 0, mine = 0; const int x = bx & 7, j = bx >> 3;
            for (int xx = 0; xx < 8; ++xx) { int tx = 0; for (int k = 0; k < 4; ++k) tx += tb[xx + 8 * k + 1] - tb[xx + 8 * k]; if (tx > 12) ok = 0;
                int f = 8 * tx - 64; f = f < 0 ? 0 : (f > 32 ? 32 : f);
                F += 32 - f; int below = j + (xx < x ? 1 : 0) - f; below = below < 0 ? 0 : (below > 32 - f ? 32 - f : below); rank += below; if (xx == x) mine = (j >= f) ? 1 : 0; }
            tb[66] = ok; tb[67] = F; tb[68] = mine ? rank : -1;
            for (int i = 0; i < MAXU; ++i) { int T = -1, e = 0, n = 0;
                if (ok) { const int U = i * 32 + j, LT = U >> 3; n = U & 7; int cum = 0;
                    for (int k = 0; k < 4; ++k) { const int ee = x + 8 * k, t0 = tb[ee], nt = tb[ee + 1] - t0; if (T < 0 && LT < cum + nt) { e = ee; T = t0 + (LT - cum); } cum += nt; } }
                else { const int L = i * G + bx; if (L < acc * 8) { T = L >> 3; n = L & 7; for (int k = 1; k < 32; ++k) e += (tb[k] <= T) ? 1 : 0; } }
                tb[80 + 4 * i] = T; tb[81 + 4 * i] = e; tb[82 + 4 * i] = n; tb[83 + 4 * i] = T < 0 ? 0 : T - tb[e]; } }
        __syncthreads();
        for (int i = 0; i < MAXU; ++i) { pg8::Unit u; if (!S.next(i, u)) break;
            if (tid < 256) { const int idx = 256 * u.lt + tid; const bool valid = idx < tb[33 + u.e];
                const int tk = valid ? ltok[u.e * SEQ + idx] : -1;
                mtok[i * 256 + tid] = tk; mw[i * 256 + tid] = valid ? lw[u.e * SEQ + idx] : 0.f; mr[i * 256 + tid] = valid ? ((const float*)(ws + WS_RSTD))[tk] : 0.f; } }
        }
        __syncthreads();
        if (IN(5)) {
            pg8::Gemm g{XN, BTGU, DM / 2};
            pg8::EpiSwiGLU E{Hb, mw, mr};
            pg8::gemm_phase<pg8::EpiSwiGLU, pg8::MoeOrder, true, true, true>(lds, g, S, E, mtok, TID());
            {
                const int units = tb[32] * 8, rem = units % G; int tailb = rem > 0 ? G - rem : G, ti = rem > 0 ? bx - rem : bx;
                if (tb[66]) { if (tb[67] > 0) { tailb = tb[67]; ti = tb[68]; } else { tailb = G; ti = bx; } }
                if (ti >= 0) { const int lane = lane_id_v(); const int q = (CV_N5 + tailb * 8 - 1) / (tailb * 8), x0 = (ti * 8 + wave) * q, x1 = (x0 + q < CV_N5) ? x0 + q : CV_N5;
                    convert_range(args.w_gate, args.w_up, args.w_down, BTGU, BTD, CV_GU + CV_D - CV_N5 + x0, CV_GU + CV_D - CV_N5 + x1, lds + wave * 8448, lane); }
            }
            if (BOTH(5)) GRID_BAR();
        }
        if (IN(6)) {
            pg8::Gemm g{Hb, BTD, DFF / 2};
            pg8::EpiYStore E{Yb};
            pg8::gemm_phase<pg8::EpiYStore, pg8::MoeOrder, true, false, true>(lds, g, S, E, nullptr, TID());
            if (BOTH(6)) GRID_BAR();
        }
        if (IN(7)) {
            const int lane = lane_id_v();
            const int* tokpos = (const int*)(ws + WS_TOKPOS);
            for (int t = gw; t < SEQ; t += NGW) {
                const int c0 = tokpos[2 * t], c1 = tokpos[2 * t + 1];
                const size_t r0 = (size_t)(256 * tb[c0 >> 16] + (c0 & 0xffff)), r1 = (size_t)(256 * tb[c1 >> 16] + (c1 & 0xffff));
                const GAS v2u* xo = (const GAS v2u*)(X1B + (size_t)t * DM) + lane; GAS f32x4* xw = (GAS f32x4*)(args.out_w + (size_t)t * DM) + lane;
                const GAS v2u* y0 = (const GAS v2u*)(Yb + r0 * DM) + lane; const GAS v2u* y1 = (const GAS v2u*)(Yb + r1 * DM) + lane;
#pragma unroll
                for (int j = 0; j < 8; ++j) { const v2u xb = __builtin_nontemporal_load(xo + 64 * j); const v2u b0 = __builtin_nontemporal_load(y0 + 64 * j), b1 = __builtin_nontemporal_load(y1 + 64 * j);
                    f32x4 a; a.x = bf_lo(xb.x); a.y = bf_hi(xb.x); a.z = bf_lo(xb.y); a.w = bf_hi(xb.y);
                    a.x = (a.x + bf_lo(b0.x)) + bf_lo(b1.x); a.y = (a.y + bf_hi(b0.x)) + bf_hi(b1.x); a.z = (a.z + bf_lo(b0.y)) + bf_lo(b1.y); a.w = (a.w + bf_hi(b0.y)) + bf_hi(b1.y);
                    __builtin_nontemporal_store(a, xw + 64 * j); }
            }
        }
    }
#undef IN
#undef BOTH
#undef GRID_BAR
#undef TID
}

extern "C" void kernel_launch(void* const* d_in, const int* in_sizes, int n_in, void* d_out, int out_size, void* d_ws, size_t ws_size, hipStream_t stream) {
    static int grid = 0;
    if (grid == 0) {
        if (n_in != 19 || out_size != SEQ * DM || ws_size < WS_END) { fprintf(stderr, "kernel_launch: unexpected sizes (n_in %d out %d ws %zu)\n", n_in, out_size, ws_size); grid = -1; return; }
        int dev = 0, cus = 0, per_cu = 0;
        if (hipGetDevice(&dev) != hipSuccess || hipDeviceGetAttribute(&cus, hipDeviceAttributeMultiprocessorCount, dev) != hipSuccess) { grid = -1; return; }
        if (hipFuncSetAttribute((const void*)hymba_fwd, hipFuncAttributeMaxDynamicSharedMemorySize, LDS_BYTES) != hipSuccess) { fprintf(stderr, "kernel_launch: hipFuncSetAttribute failed\n"); grid = -1; return; }
        if (hipOccupancyMaxActiveBlocksPerMultiprocessor(&per_cu, (const void*)hymba_fwd, 512, LDS_BYTES) != hipSuccess || per_cu < 1) fprintf(stderr, "kernel_launch: occupancy query reports %d\n", per_cu);
        (void)hipGetLastError();
        grid = cus;
    }
    if (grid < 0) return;
    if (hipMemsetAsync((char*)d_ws + WS_CTL, 0, CTL_ZERO_BYTES, stream) != hipSuccess) return;
    Args a{};
    a.x = (const float*)d_in[0]; a.norm1_g = (const float*)d_in[1]; a.w_in = (const float*)d_in[2]; a.q_norm_g = (const float*)d_in[3]; a.k_norm_g = (const float*)d_in[4];
    a.conv_w = (const float*)d_in[5]; a.conv_b = (const float*)d_in[6]; a.conv_ln_g = (const float*)d_in[7]; a.conv_ln_b = (const float*)d_in[8]; a.rel_bias = (const float*)d_in[9];
    a.w_out = (const float*)d_in[10]; a.norm2_g = (const float*)d_in[11]; a.w_rg = (const float*)d_in[12]; a.b_rg = (const float*)d_in[13]; a.w_re = (const float*)d_in[14]; a.b_re = (const float*)d_in[15];
    a.w_gate = (const float*)d_in[16]; a.w_up = (const float*)d_in[17]; a.w_down = (const float*)d_in[18];
    a.out = (float*)d_out; a.out_w = (float*)d_out; a.ws = (unsigned char*)d_ws;
    if (N_LAUNCHES == 1) { a.ph_lo = 0; a.ph_hi = N_PHASES; hipLaunchKernelGGL(hymba_fwd, dim3(grid), dim3(512), LDS_BYTES, stream, a); }
    else {
#ifndef MK_PROBE
#define MK_PROBE -1
#endif
        for (int p = 0; p < N_PHASES; ++p) { a.ph_lo = p; a.ph_hi = p + 1; hipLaunchKernelGGL(hymba_fwd, dim3(grid), dim3(512), LDS_BYTES, stream, a);
            if (p == MK_PROBE) { Args b = a;
                if (p == 7) b.out_w = (float*)((char*)d_ws + 704 * MiB);
                if (p == 4) { b.ws = (unsigned char*)d_ws + 700 * MiB; (void)hipMemsetAsync(b.ws, 0, CTL_ZERO_BYTES, stream); }
                hipLaunchKernelGGL(hymba_fwd, dim3(grid), dim3(512), LDS_BYTES, stream, b); } }
    }
}
```
